# Optimizing an MI355X kernel written in HIP

```python
import math
import jax, jax.numpy as jnp
from jax import lax
import numpy as np

D_MODEL = 2048
BATCH = 4
SEQ = 2048
DEPTH = 4
DEC_BATCH = 32
DEC_SEQ = 1
PAST_LEN = 16384
PAGE_SIZE = 128

D_MIX = D_MODEL
D_POOL = D_MIX // 4
POOL_WINDOWS = (2, 4, 8, 16)
N_POOL_GROUPS = len(POOL_WINDOWS)
POOL_GROUP = D_POOL // N_POOL_GROUPS
POOL_STATE = max(POOL_WINDOWS) - 1
D_CONV = D_MIX // 4
CONV_WIDTH = 31
CONV_STATE = CONV_WIDTH - 1
D_ATTN = D_MIX // 2
HEAD_DIM = 64
N_HEADS = D_ATTN // HEAD_DIM
N_KV_HEADS = 4
GQA_GROUP = N_HEADS // N_KV_HEADS
D_KV = N_KV_HEADS * HEAD_DIM
WINDOW = 128
BLOCK = WINDOW
ATTN_SCALE = HEAD_DIM ** -0.5
NEG_INF = -1e30
N_BUCKETS = 32
MAX_EXACT = N_BUCKETS // 2
MAX_DISTANCE = 128
D_IN = D_POOL + 2 * D_CONV + D_ATTN + 2 * D_KV
SPLITS = (D_POOL, D_POOL + D_CONV, D_POOL + 2 * D_CONV,
          D_POOL + 2 * D_CONV + D_ATTN, D_POOL + 2 * D_CONV + D_ATTN + D_KV)
D_FF = 5632
D_PLE = 256
LN_EPS = 1e-5
ALPHA = (2 * DEPTH) ** 0.25
BETA = (8 * DEPTH) ** -0.25

kernel_name = 'hybrid_pool_conv_swa_macaron_deepnorm_step'


def _layer_norm(x, g, b):
    xf = x.astype(jnp.float32)
    mu = jnp.mean(xf, axis=-1, keepdims=True)
    var = jnp.mean(jnp.square(xf - mu), axis=-1, keepdims=True)
    y = (xf - mu) * lax.rsqrt(var + LN_EPS) * g.astype(jnp.float32) + b.astype(jnp.float32)
    return y.astype(x.dtype)


def _swiglu(x, w_gate, w_up, w_down):
    return (jax.nn.silu(x @ w_gate) * (x @ w_up)) @ w_down


def _t5_bucket(dist):
    n = jnp.maximum(dist, 0)
    nf = jnp.maximum(n, 1).astype(jnp.float32)
    log_b = MAX_EXACT + (jnp.log(nf / MAX_EXACT) / math.log(MAX_DISTANCE / MAX_EXACT)
                         * (N_BUCKETS - MAX_EXACT)).astype(jnp.int32)
    return jnp.where(n < MAX_EXACT, n, jnp.minimum(log_b, N_BUCKETS - 1))


def _multiscale_pool(u_ext, positions, w_pool, pool_scale):
    L = positions.shape[0]
    uf = u_ext.astype(jnp.float32)
    c = jnp.pad(jnp.cumsum(uf, axis=1), ((0, 0), (1, 0), (0, 0)))
    cur = uf[:, POOL_STATE:]
    diffs = []
    for g, w in enumerate(POOL_WINDOWS):
        sl = slice(g * POOL_GROUP, (g + 1) * POOL_GROUP)
        win_sum = (c[:, POOL_STATE + 1:POOL_STATE + 1 + L, sl]
                   - c[:, POOL_STATE + 1 - w:POOL_STATE + 1 - w + L, sl])
        count = jnp.minimum(positions + 1, w).astype(jnp.float32)[None, :, None]
        diffs.append(win_sum / count - cur[..., sl])
    d = jnp.stack(diffs, axis=2).astype(u_ext.dtype)
    y = jnp.einsum('blgc,gcd->blgd', d, w_pool)
    return y.reshape(y.shape[0], L, D_POOL) * pool_scale


def _conformer_conv(v_ext, w_dw, b_dw, ln_g, ln_b, w_pw):
    y = lax.conv_general_dilated(v_ext, w_dw[:, None, :], window_strides=(1,), padding='VALID',
                                 dimension_numbers=('NWC', 'WIO', 'NWC'),
                                 feature_group_count=D_CONV)
    y = jax.nn.silu(_layer_norm(y + b_dw, ln_g, ln_b))
    return y @ w_pw


def _window_softmax(q, k, v, q_pos, k_pos, rel_bias, sinks):
    B, NB, Q = q.shape[:3]
    K = k.shape[2]
    qg = q.reshape(B, NB, Q, N_KV_HEADS, GQA_GROUP, HEAD_DIM)
    s = jnp.einsum('bnqhgd,bnshd->bnhgqs', qg, k,
                   preferred_element_type=jnp.float32) * ATTN_SCALE
    dist = q_pos[:, :, None] - k_pos[:, None, :]
    valid = (dist >= 0) & (dist < WINDOW) & (k_pos[:, None, :] >= 0)
    bias = rel_bias[_t5_bucket(dist)].astype(jnp.float32)
    bias = jnp.moveaxis(bias, -1, 1).reshape(NB, N_KV_HEADS, GQA_GROUP, Q, K)
    s = jnp.where(valid[None, :, None, None], s + bias[None], NEG_INF)
    sink = sinks.astype(jnp.float32).reshape(1, 1, N_KV_HEADS, GQA_GROUP, 1, 1)
    m = jnp.maximum(jnp.max(s, axis=-1, keepdims=True), sink)
    e = jnp.exp(s - m)
    prob = e / (jnp.sum(e, axis=-1, keepdims=True) + jnp.exp(sink - m))
    o = jnp.einsum('bnhgqs,bnshd->bnqhgd', prob.astype(v.dtype), v)
    return o.reshape(B, NB, Q, D_ATTN)


def _token_mixer(h, pos0, pool_past, conv_past, k_past, v_past, prm, l):
    B, L, _ = h.shape
    z = h @ prm['w_in'][l]
    u, a, gt, q, k, v = jnp.split(z, SPLITS, axis=-1)
    positions = pos0 + jnp.arange(L, dtype=jnp.int32)
    u_ext = jnp.concatenate([pool_past, u], axis=1)
    y_pool = _multiscale_pool(u_ext, positions, prm['w_pool'][l], prm['pool_scale'][l])
    c_ext = jnp.concatenate([conv_past, a * jax.nn.sigmoid(gt)], axis=1)
    y_conv = _conformer_conv(c_ext, prm['w_dw'][l], prm['b_dw'][l], prm['conv_ln_g'][l],
                             prm['conv_ln_b'][l], prm['w_pw'][l])
    q = q.reshape(B, L, N_HEADS, HEAD_DIM)
    k = k.reshape(B, L, N_KV_HEADS, HEAD_DIM)
    v = v.reshape(B, L, N_KV_HEADS, HEAD_DIM)
    if k_past is None:
        nb = L // BLOCK
        qb = q.reshape(B, nb, BLOCK, N_HEADS, HEAD_DIM)
        kb = k.reshape(B, nb, BLOCK, N_KV_HEADS, HEAD_DIM)
        vb = v.reshape(B, nb, BLOCK, N_KV_HEADS, HEAD_DIM)
        prev = lambda t: jnp.pad(t, ((0, 0), (1, 0), (0, 0), (0, 0), (0, 0)))[:, :-1]
        k_band = jnp.concatenate([prev(kb), kb], axis=2)
        v_band = jnp.concatenate([prev(vb), vb], axis=2)
        q_pos = positions.reshape(nb, BLOCK)
        k_pos = (pos0 + (jnp.arange(nb, dtype=jnp.int32)[:, None] - 1) * BLOCK
                 + jnp.arange(2 * BLOCK, dtype=jnp.int32)[None])
        y_attn = _window_softmax(qb, k_band, v_band, q_pos, k_pos, prm['rel_bias'],
                                 prm['sinks'][l]).reshape(B, L, D_ATTN)
        k_keep, v_keep = k[:, -WINDOW:], v[:, -WINDOW:]
    else:
        k_ext = jnp.concatenate([k_past, k], axis=1)
        v_ext = jnp.concatenate([v_past, v], axis=1)
        q_pos = positions[None]
        k_pos = (pos0 - WINDOW + jnp.arange(WINDOW + L, dtype=jnp.int32))[None]
        y_attn = _window_softmax(q[:, None], k_ext[:, None], v_ext[:, None], q_pos, k_pos,
                                 prm['rel_bias'], prm['sinks'][l]).reshape(B, L, D_ATTN)
        k_keep, v_keep = k_ext[:, -WINDOW:], v_ext[:, -WINDOW:]
    y = jnp.concatenate([y_pool, y_conv, y_attn], axis=-1) @ prm['w_out'][l]
    return y, (k_keep, v_keep, u_ext[:, -POOL_STATE:], c_ext[:, -CONV_STATE:])


def _trunk(x, p, pos0, cache_k, cache_v, state_pool, state_conv, prm):
    prompt = cache_k is None
    B = x.shape[0]
    h = x
    new = ([], [], [], [])
    for l in range(DEPTH):
        h = _layer_norm(ALPHA * h + 0.5 * _swiglu(h, prm['ffn1_w_gate'][l], prm['ffn1_w_up'][l],
                                                  prm['ffn1_w_down'][l]),
                        prm['ln1_g'][l], prm['ln1_b'][l])
        if prompt:
            pool_past = jnp.zeros((B, POOL_STATE, D_POOL), h.dtype)
            conv_past = jnp.zeros((B, CONV_STATE, D_CONV), h.dtype)
            k_past, v_past = None, None
        else:
            pool_past, conv_past = state_pool[l], state_conv[l]
            k_past, v_past = cache_k[l], cache_v[l]
        y, st = _token_mixer(h, pos0, pool_past, conv_past, k_past, v_past, prm, l)
        h = _layer_norm(ALPHA * h + y, prm['ln2_g'][l], prm['ln2_b'][l])
        h = _layer_norm(ALPHA * h + 0.5 * _swiglu(h, prm['ffn2_w_gate'][l], prm['ffn2_w_up'][l],
                                                  prm['ffn2_w_down'][l]),
                        prm['ln3_g'][l], prm['ln3_b'][l])
        h = h + jax.nn.sigmoid(h @ prm['w_ple_gate'][l]) * (p[l] @ prm['w_ple'][l])
        for lst, s in zip(new, st):
            lst.append(s)
    return h, [jnp.stack(s_list) for s_list in new]


def setup_inputs(seed: int = 0) -> dict:
    key = jax.random.key(seed)
    ks = iter(jax.random.split(key, 48))
    nrm = lambda shape, scale: jax.random.normal(next(ks), shape, jnp.float32) * scale
    gain = lambda shape: 1.0 + nrm(shape, 0.02)
    return {
        'x_prompt': nrm((BATCH, SEQ, D_MODEL), 1.0),
        'x_sample': nrm((DEC_BATCH, DEC_SEQ, D_MODEL), 1.0),
        'p_prompt': nrm((DEPTH, BATCH, SEQ, D_PLE), 1.0),
        'p_sample': nrm((DEPTH, DEC_BATCH, DEC_SEQ, D_PLE), 1.0),
        'cache_k': nrm((DEPTH, DEC_BATCH, WINDOW, N_KV_HEADS, HEAD_DIM), 1.0),
        'cache_v': nrm((DEPTH, DEC_BATCH, WINDOW, N_KV_HEADS, HEAD_DIM), 1.0),
        'state_pool': nrm((DEPTH, DEC_BATCH, POOL_STATE, D_POOL), 1.0),
        'state_conv': nrm((DEPTH, DEC_BATCH, CONV_STATE, D_CONV), 0.5),
        'rel_bias': nrm((N_BUCKETS, N_HEADS), 0.5),
        'ln1_g': gain((DEPTH, D_MODEL)),
        'ln1_b': nrm((DEPTH, D_MODEL), 0.02),
        'ffn1_w_gate': nrm((DEPTH, D_MODEL, D_FF), D_MODEL ** -0.5),
        'ffn1_w_up': nrm((DEPTH, D_MODEL, D_FF), D_MODEL ** -0.5),
        'ffn1_w_down': nrm((DEPTH, D_FF, D_MODEL), BETA * D_FF ** -0.5),
        'w_in': nrm((DEPTH, D_MODEL, D_IN), D_MODEL ** -0.5),
        'w_pool': nrm((DEPTH, N_POOL_GROUPS, POOL_GROUP, POOL_GROUP), POOL_GROUP ** -0.5),
        'pool_scale': gain((DEPTH, D_POOL)),
        'w_dw': nrm((DEPTH, CONV_WIDTH, D_CONV), CONV_WIDTH ** -0.5),
        'b_dw': nrm((DEPTH, D_CONV), 0.01),
        'conv_ln_g': gain((DEPTH, D_CONV)),
        'conv_ln_b': nrm((DEPTH, D_CONV), 0.02),
        'w_pw': nrm((DEPTH, D_CONV, D_CONV), D_CONV ** -0.5),
        'sinks': nrm((DEPTH, N_HEADS), 0.5),
        'w_out': nrm((DEPTH, D_MIX, D_MODEL), BETA * D_MIX ** -0.5),
        'ln2_g': gain((DEPTH, D_MODEL)),
        'ln2_b': nrm((DEPTH, D_MODEL), 0.02),
        'ffn2_w_gate': nrm((DEPTH, D_MODEL, D_FF), D_MODEL ** -0.5),
        'ffn2_w_up': nrm((DEPTH, D_MODEL, D_FF), D_MODEL ** -0.5),
        'ffn2_w_down': nrm((DEPTH, D_FF, D_MODEL), BETA * D_FF ** -0.5),
        'ln3_g': gain((DEPTH, D_MODEL)),
        'ln3_b': nrm((DEPTH, D_MODEL), 0.02),
        'w_ple_gate': nrm((DEPTH, D_MODEL, D_MODEL), D_MODEL ** -0.5),
        'w_ple': nrm((DEPTH, D_PLE, D_MODEL), D_PLE ** -0.5),
    }


def reference(x_prompt, x_sample, p_prompt, p_sample, cache_k, cache_v, state_pool, state_conv,
              rel_bias, ln1_g, ln1_b, ffn1_w_gate, ffn1_w_up, ffn1_w_down, w_in, w_pool,
              pool_scale, w_dw, b_dw, conv_ln_g, conv_ln_b, w_pw, sinks, w_out, ln2_g, ln2_b,
              ffn2_w_gate, ffn2_w_up, ffn2_w_down, ln3_g, ln3_b, w_ple_gate, w_ple):
    prm = dict(rel_bias=rel_bias, ln1_g=ln1_g, ln1_b=ln1_b, ffn1_w_gate=ffn1_w_gate,
               ffn1_w_up=ffn1_w_up, ffn1_w_down=ffn1_w_down, w_in=w_in, w_pool=w_pool,
               pool_scale=pool_scale, w_dw=w_dw, b_dw=b_dw, conv_ln_g=conv_ln_g,
               conv_ln_b=conv_ln_b, w_pw=w_pw, sinks=sinks, w_out=w_out, ln2_g=ln2_g,
               ln2_b=ln2_b, ffn2_w_gate=ffn2_w_gate, ffn2_w_up=ffn2_w_up,
               ffn2_w_down=ffn2_w_down, ln3_g=ln3_g, ln3_b=ln3_b, w_ple_gate=w_ple_gate,
               w_ple=w_ple)
    y_prompt, (new_k_prompt, new_v_prompt, new_pool_prompt, new_conv_prompt) = _trunk(
        x_prompt, p_prompt, 0, None, None, None, None, prm)
    y_sample, (new_k_sample, new_v_sample, new_pool_sample, new_conv_sample) = _trunk(
        x_sample, p_sample, PAST_LEN, cache_k, cache_v, state_pool, state_conv, prm)
    return (y_prompt, y_sample, new_k_prompt, new_v_prompt, new_pool_prompt, new_conv_prompt,
            new_k_sample, new_v_sample, new_pool_sample, new_conv_sample)
```

```cpp
#include <hip/hip_runtime.h>
#include <cstdio>
#include <cstdint>
#define MK_ONE_LAUNCH 0
namespace pg8 {
#define PG8_LAS __attribute__((address_space(3)))
typedef unsigned short bf16_t;
typedef short bf16x8 __attribute__((ext_vector_type(8)));
typedef float f32x4 __attribute__((ext_vector_type(4)));
typedef unsigned u32x4 __attribute__((ext_vector_type(4)));
constexpr int BM = 256, BK = 64, HALF = 128, HTB = HALF * BK * 2  , STAGE_BYTES = 8 * HTB, NXCD = 8, WGM = 8;

__host__ __device__ __forceinline__ int lds_byte(int r, int c) { const int st = (r >> 4) * 2 + (c >> 5), rr = r & 15, cc = c & 31, ob = rr * 64 + cc * 2; return st * 1024 + (ob ^ (((ob >> 9) & 1) << 5)); }
__host__ __device__ __forceinline__ void stage_rc(int b, int& R, int& C) { const int st = b / 1024, sb = b % 1024, swz = sb ^ (((sb >> 9) & 1) << 5); R = (st >> 1) * 16 + swz / 64; C = (st & 1) * 32 + (swz % 64) / 2; }
__host__ __device__ __forceinline__ int perm32(int rho) { const int n = rho >> 4, i = rho & 15; return 8 * (i >> 2) + 4 * n + (i & 3); }

struct Unit { int pm, pn; };
struct Gemm { const bf16_t* A; const bf16_t* Bt; int M, N, K; };

struct StaticOrder {
    int nM, nN, nwg, G, c;
    __host__ __device__ void init(int M, int N, int G_, int c_) { nM = M / BM; nN = N / BM; nwg = nM * nN; G = G_; c = c_; }
    __host__ __device__ bool next(int i, Unit& u) const {
        const long L = (long)i * G + c; if (L >= nwg) return false;
        int wgid = (int)L; { const int q = nwg / NXCD, r = nwg % NXCD, xcd = wgid % NXCD, off = wgid / NXCD; wgid = (xcd < r ? xcd * (q + 1) : r * (q + 1) + (xcd - r) * q) + off; }
        const int nig = WGM * nN, gid = wgid / nig, fm = gid * WGM, gsz = (nM - fm) < WGM ? (nM - fm) : WGM;
        u.pm = fm + ((wgid % nig) % gsz); u.pn = (wgid % nig) / gsz; return true;
    }
    __device__ __forceinline__ void a_ready(const Unit&) const {}
    __device__ __forceinline__ void done(const Unit&) const {}
};

__device__ __forceinline__ unsigned cvt_pk_bf16(float lo, float hi) { unsigned r; asm volatile("v_cvt_pk_bf16_f32 %0, %1, %2" : "=v"(r) : "v"(lo), "v"(hi)); return r; }
typedef float f32x2 __attribute__((ext_vector_type(2)));
__device__ __forceinline__ f32x2 gelu_pk(f32x2 v) {
    const f32x2 av = __builtin_elementwise_abs(v), d = av * 0.2316418882f + 1.0f;
    f32x2 t; t.x = __builtin_amdgcn_rcpf(d.x); t.y = __builtin_amdgcn_rcpf(d.y);
    f32x2 q = t * 0.5307027145f + (-0.7265760135f); q = q * t + 0.7107068705f; q = q * t + (-0.142248368f); q = q * t + 0.127414796f; q = q * t;
    const f32x2 s = (v * v) * (-0.72134752044f);
    f32x2 e; e.x = __builtin_amdgcn_exp2f(s.x); e.y = __builtin_amdgcn_exp2f(s.y);
    const f32x2 m = v * (q * e), r = v - m;
    f32x2 o; o.x = v.x < 0.f ? m.x : r.x; o.y = v.y < 0.f ? m.y : r.y; return o;
}

template <int ACT  > struct EpiBf16 {
    static constexpr bool PERM = true, AFTER_DRAIN = false; static_assert(ACT == 0 || ACT == 1, "EpiBf16: ACT is 0 (none) or 1 (gelu_pk)");
    bf16_t* O; int ldc; const float* bias; int split_cols; size_t split_stride; float scale0;
    __device__ __forceinline__ void operator()(const f32x4 (&acc)[2][2][4][2], const Unit& u, int wr, int wc, int fr, int fq) const {
        const int row0 = u.pm * BM + wr * 64 + fr; int colt = u.pn * BM; bf16_t* base = O;
        float sc = 1.f; if (split_cols) { const int t = colt / split_cols; base += (size_t)t * split_stride; colt -= t * split_cols; if (t == 0) sc = scale0; }
        const int col0 = colt + wc * 32 + 8 * fq, bcol0 = u.pn * BM + wc * 32 + 8 * fq;
        f32x4 bv[2][2];
#pragma unroll
        for (int bj = 0; bj < 2; ++bj)
#pragma unroll
            for (int n = 0; n < 2; ++n) bv[bj][n] = bias ? *(const f32x4*)(bias + bcol0 + bj * HALF + 4 * n) : (f32x4){0.f, 0.f, 0.f, 0.f};
#pragma unroll
        for (int ai = 0; ai < 2; ++ai)
#pragma unroll
            for (int m = 0; m < 4; ++m) { bf16_t* rowp = base + (size_t)(row0 + ai * HALF + m * 16) * ldc + col0;
#pragma unroll
                for (int bj = 0; bj < 2; ++bj) { f32x4 v0 = acc[ai][bj][m][0] + bv[bj][0], v1 = acc[ai][bj][m][1] + bv[bj][1];
                    if (ACT == 1) { f32x2 a = gelu_pk((f32x2){v0[0], v0[1]}), b = gelu_pk((f32x2){v0[2], v0[3]}), c = gelu_pk((f32x2){v1[0], v1[1]}), d = gelu_pk((f32x2){v1[2], v1[3]});
                        v0 = (f32x4){a.x, a.y, b.x, b.y}; v1 = (f32x4){c.x, c.y, d.x, d.y}; }
                    v0 = v0 * sc; v1 = v1 * sc; u32x4 w; w.x = cvt_pk_bf16(v0[0], v0[1]); w.y = cvt_pk_bf16(v0[2], v0[3]); w.z = cvt_pk_bf16(v1[0], v1[1]); w.w = cvt_pk_bf16(v1[2], v1[3]);
                    *(u32x4*)(rowp + bj * HALF) = w; } }
    }
};
__device__ __forceinline__ float silu_f(float x) { return x * __builtin_amdgcn_rcpf(1.0f + __builtin_amdgcn_exp2f(-1.4426950408889634f * x)); }
__device__ __forceinline__ float sigmoid_f(float x) { return __builtin_amdgcn_rcpf(1.0f + __builtin_amdgcn_exp2f(-1.4426950408889634f * x)); }
struct EpiF32 {
    static constexpr bool PERM = false, AFTER_DRAIN = false;
    float* C; int ldc;
    __device__ __forceinline__ void operator()(const f32x4 (&acc)[2][2][4][2], const Unit& u, int wr, int wc, int fr, int fq) const {
        const int row0 = u.pm * BM + wr * 64 + fr, col0 = u.pn * BM + wc * 32 + 4 * fq;
#pragma unroll
        for (int ai = 0; ai < 2; ++ai)
#pragma unroll
            for (int m = 0; m < 4; ++m) { float* rowp = C + (size_t)(row0 + ai * HALF + m * 16) * ldc + col0;
#pragma unroll
                for (int bj = 0; bj < 2; ++bj)
#pragma unroll
                    for (int n = 0; n < 2; ++n) *(f32x4*)(rowp + bj * HALF + n * 16) = acc[ai][bj][m][n]; }
    }
};
struct EpiSwiGLU {
    static constexpr bool PERM = true, AFTER_DRAIN = false;
    bf16_t* O; int ldc;
    __device__ __forceinline__ void operator()(const f32x4 (&acc)[2][2][4][2], const Unit& u, int wr, int wc, int fr, int fq) const {
        const int row0 = u.pm * BM + wr * 64 + fr, col0 = u.pn * HALF + wc * 32 + 8 * fq;
#pragma unroll
        for (int ai = 0; ai < 2; ++ai)
#pragma unroll
            for (int m = 0; m < 4; ++m) { bf16_t* rowp = O + (size_t)(row0 + ai * HALF + m * 16) * ldc + col0;
                const f32x4 g0 = acc[ai][0][m][0], g1 = acc[ai][0][m][1], u0 = acc[ai][1][m][0], u1 = acc[ai][1][m][1];
                u32x4 w;
                w.x = cvt_pk_bf16(silu_f(g0[0]) * u0[0], silu_f(g0[1]) * u0[1]); w.y = cvt_pk_bf16(silu_f(g0[2]) * u0[2], silu_f(g0[3]) * u0[3]);
                w.z = cvt_pk_bf16(silu_f(g1[0]) * u1[0], silu_f(g1[1]) * u1[1]); w.w = cvt_pk_bf16(silu_f(g1[2]) * u1[2], silu_f(g1[3]) * u1[3]);
                *(u32x4*)rowp = w; }
    }
};
template <class Epi, class Sched, bool ALIGN_EPI = false, bool SP2 = false>
__device__ __forceinline__ void gemm_phase(PG8_LAS unsigned char* lds, const Gemm g, const Sched& S, const Epi& E) {
    int tid_ = threadIdx.x; asm volatile("" : "+v"(tid_));
    const int tid = tid_, wid = __builtin_amdgcn_readfirstlane(tid >> 6), lane = tid & 63, wr = wid >> 2, wc = wid & 3, fr = lane & 15, fq = lane >> 4;
    const int K = g.K, nt = K / BK;
    unsigned voffA[2], voffB[2];
#pragma unroll
    for (int i = 0; i < 2; ++i) { int R, C; stage_rc(tid * 16 + i * 8192, R, C); const int Rb = Epi::PERM ? ((R & ~31) + perm32(R & 31)) : R;
        voffA[i] = (unsigned)(R * K + C) * 2u; voffB[i] = (unsigned)(Rb * K + C) * 2u; }
    const size_t kstep = (size_t)(BK * 2);
    const size_t hstep = (size_t)HALF * K * 2;
    const size_t tstep = 2 * hstep;
    const unsigned ldsw = (unsigned)wid * 1024u;
    const int aoff = lds_byte(wr * 64 + fr, fq * 8), boff = lds_byte(wc * 32 + fr, fq * 8);
#define PG8_SA(b, h) (((b) * 2 + (h)) * HTB)
#define PG8_SB(b, h) ((4 + (b) * 2 + (h)) * HTB)
#define PG8_STAGE(bufoff, gbase, voff) do { _Pragma("unroll") for (int _i = 0; _i < 2; ++_i) \
        __builtin_amdgcn_global_load_lds((const unsigned*)((const char*)(gbase) + (voff)[_i]), (PG8_LAS unsigned*)(lds + (bufoff) + ldsw + _i * 8192), 16, 0, 0); } while (0)
#define PG8_LDA(dst, b, h) do { _Pragma("unroll") for (int m = 0; m < 4; ++m) _Pragma("unroll") for (int k = 0; k < 2; ++k) dst[m][k] = *(const PG8_LAS bf16x8*)(lds + PG8_SA(b, h) + aoff + m * 2048 + k * 1024); } while (0)
#define PG8_LDB(dst, b, h) do { _Pragma("unroll") for (int n = 0; n < 2; ++n) _Pragma("unroll") for (int k = 0; k < 2; ++k) dst[n][k] = *(const PG8_LAS bf16x8*)(lds + PG8_SB(b, h) + boff + n * 2048 + k * 1024); } while (0)
#define PG8_MMA(ai, bj, At, Bt) do { __builtin_amdgcn_s_setprio(1); _Pragma("unroll") for (int m = 0; m < 4; ++m) _Pragma("unroll") for (int n = 0; n < 2; ++n) _Pragma("unroll") for (int k = 0; k < 2; ++k) \
        acc[ai][bj][m][n] = __builtin_amdgcn_mfma_f32_16x16x32_bf16(Bt[n][k], At[m][k], acc[ai][bj][m][n], 0, 0, 0); __builtin_amdgcn_s_setprio(0); } while (0)
#define PG8_WAIT_V(n) asm volatile("s_waitcnt vmcnt(" #n ")" ::: "memory")
#define PG8_WAIT_L(n) asm volatile("s_waitcnt lgkmcnt(" #n ")" ::: "memory")
#define PG8_BAR __builtin_amdgcn_s_barrier()
#define PG8_SCHED __builtin_amdgcn_sched_barrier(0)
    Unit cur, nxt; int ui = 0;
    if (!S.next(0, cur)) return;
    f32x4 acc[2][2][4][2];
#pragma unroll
    for (int a = 0; a < 2; ++a)
#pragma unroll
        for (int b = 0; b < 2; ++b)
#pragma unroll
            for (int m = 0; m < 4; ++m)
#pragma unroll
                for (int n = 0; n < 2; ++n) acc[a][b][m][n] = (f32x4){0.f, 0.f, 0.f, 0.f};
    bf16x8 At[4][2], B0[2][2], B1[2][2];
    const char* cA = (const char*)g.A + (size_t)cur.pm * tstep; const char* cB = (const char*)g.Bt + (size_t)cur.pn * tstep;
    S.a_ready(cur);
    if constexpr (SP2) {
        PG8_STAGE(PG8_SB(0, 0), cB, voffB); PG8_STAGE(PG8_SB(0, 1), cB + hstep, voffB); PG8_STAGE(PG8_SA(0, 0), cA, voffA); PG8_STAGE(PG8_SA(0, 1), cA + hstep, voffA);
        if (wr == 1) PG8_BAR;
        PG8_WAIT_V(2); PG8_BAR;
        PG8_STAGE(PG8_SB(1, 0), cB + kstep, voffB); PG8_STAGE(PG8_SA(1, 0), cA + kstep, voffA); PG8_STAGE(PG8_SB(1, 1), cB + hstep + kstep, voffB);
        PG8_WAIT_V(6); PG8_BAR;
    } else {
        PG8_STAGE(PG8_SB(0, 0), cB, voffB); PG8_STAGE(PG8_SA(0, 0), cA, voffA); PG8_STAGE(PG8_SB(0, 1), cB + hstep, voffB); PG8_STAGE(PG8_SA(0, 1), cA + hstep, voffA);
        if (wr == 1) PG8_BAR;
        PG8_WAIT_V(4); PG8_BAR;
        PG8_STAGE(PG8_SB(1, 0), cB + kstep, voffB); PG8_STAGE(PG8_SA(1, 0), cA + kstep, voffA); PG8_STAGE(PG8_SB(1, 1), cB + hstep + kstep, voffB);
        PG8_WAIT_V(6); PG8_BAR;
    }
    for (;;) {
        const bool has_next = S.next(ui + 1, nxt);
        const char* nA = has_next ? (const char*)g.A + (size_t)nxt.pm * tstep : cA; const char* nB = has_next ? (const char*)g.Bt + (size_t)nxt.pn * tstep : cB;
        for (int t = 0; t < nt; t += 2) {
            const bool last = (t == nt - 2);
            const char* a1 = cA + (size_t)(t + 1) * kstep;
            const char* a2 = last ? nA : cA + (size_t)(t + 2) * kstep; const char* b2 = last ? nB : cB + (size_t)(t + 2) * kstep;
            const char* a3 = a2 + kstep; const char* b3 = b2 + kstep;
            if (last && has_next) S.a_ready(nxt);
            if constexpr (SP2) {
            PG8_LDB(B0, 0, 0); PG8_LDB(B1, 0, 1); PG8_SCHED; PG8_LDA(At, 0, 0); PG8_STAGE(PG8_SA(1, 1), a1 + hstep, voffA);
            PG8_WAIT_V(8); PG8_WAIT_L(0); PG8_BAR; PG8_MMA(0, 0, At, B0); PG8_MMA(0, 1, At, B1); PG8_BAR; PG8_SCHED;
            PG8_LDA(At, 0, 1); PG8_STAGE(PG8_SB(0, 0), b2, voffB); PG8_STAGE(PG8_SB(0, 1), b2 + hstep, voffB); PG8_STAGE(PG8_SA(0, 0), a2, voffA);
            PG8_WAIT_V(8); PG8_WAIT_L(0); PG8_BAR; PG8_MMA(1, 0, At, B0); PG8_MMA(1, 1, At, B1); PG8_BAR; PG8_SCHED;
            PG8_LDB(B0, 1, 0); PG8_LDB(B1, 1, 1); PG8_SCHED; PG8_LDA(At, 1, 0); PG8_STAGE(PG8_SA(0, 1), a2 + hstep, voffA);
            PG8_WAIT_V(8); PG8_WAIT_L(0); PG8_BAR; PG8_MMA(0, 0, At, B0); PG8_MMA(0, 1, At, B1); PG8_BAR; PG8_SCHED;
            PG8_LDA(At, 1, 1); PG8_STAGE(PG8_SB(1, 0), b3, voffB); PG8_STAGE(PG8_SB(1, 1), b3 + hstep, voffB); PG8_STAGE(PG8_SA(1, 0), a3, voffA);
            PG8_WAIT_V(8); PG8_WAIT_L(0); PG8_BAR; PG8_MMA(1, 0, At, B0); PG8_MMA(1, 1, At, B1); PG8_BAR; PG8_SCHED;
            } else {
            PG8_LDB(B0, 0, 0); PG8_SCHED; PG8_LDA(At, 0, 0); PG8_STAGE(PG8_SA(1, 1), a1 + hstep, voffA);
            PG8_WAIT_L(8); PG8_BAR; PG8_WAIT_L(0); PG8_MMA(0, 0, At, B0); PG8_BAR; PG8_SCHED;
            PG8_LDB(B1, 0, 1); PG8_STAGE(PG8_SB(0, 0), b2, voffB);
            PG8_BAR; PG8_WAIT_L(0); PG8_MMA(0, 1, At, B1); PG8_BAR;
            PG8_LDA(At, 0, 1); PG8_STAGE(PG8_SA(0, 0), a2, voffA);
            PG8_BAR; PG8_WAIT_L(0); PG8_MMA(1, 0, At, B0); PG8_BAR; PG8_SCHED;
            PG8_STAGE(PG8_SB(0, 1), b2 + hstep, voffB);
            PG8_WAIT_V(6); PG8_BAR; PG8_MMA(1, 1, At, B1); PG8_BAR;
            PG8_LDB(B0, 1, 0); PG8_SCHED; PG8_LDA(At, 1, 0); PG8_STAGE(PG8_SA(0, 1), a2 + hstep, voffA);
            PG8_WAIT_L(8); PG8_BAR; PG8_WAIT_L(0); PG8_MMA(0, 0, At, B0); PG8_BAR; PG8_SCHED;
            PG8_LDB(B1, 1, 1); PG8_STAGE(PG8_SB(1, 0), b3, voffB);
            PG8_BAR; PG8_WAIT_L(0); PG8_MMA(0, 1, At, B1); PG8_BAR;
            PG8_LDA(At, 1, 1); PG8_STAGE(PG8_SA(1, 0), a3, voffA);
            PG8_BAR; PG8_WAIT_L(0); PG8_MMA(1, 0, At, B0); PG8_BAR; PG8_SCHED;
            PG8_STAGE(PG8_SB(1, 1), b3 + hstep, voffB);
            PG8_WAIT_V(6); PG8_BAR; PG8_MMA(1, 1, At, B1); PG8_BAR;
            }
        }
        if constexpr (ALIGN_EPI) { if (wr == 0) PG8_BAR; }
        if constexpr (!Epi::AFTER_DRAIN) { E(acc, cur, wr, wc, fr, fq); S.done(cur); }
        if (!has_next) break;
#pragma unroll
        for (int a = 0; a < 2; ++a)
#pragma unroll
            for (int b = 0; b < 2; ++b)
#pragma unroll
                for (int m = 0; m < 4; ++m)
#pragma unroll
                    for (int n = 0; n < 2; ++n) acc[a][b][m][n] = (f32x4){0.f, 0.f, 0.f, 0.f};
        cur = nxt; cA = nA; cB = nB; ++ui;
        if constexpr (ALIGN_EPI) { if (wr == 1) PG8_BAR; }
    }
    PG8_WAIT_V(0);
    if constexpr (!ALIGN_EPI) { if (wr == 0) PG8_BAR; }
    PG8_BAR;
    if constexpr (Epi::AFTER_DRAIN) { E.fused(acc, cur, wr, wc, fr, fq, lds, wid, lane); S.done(cur); }
#undef PG8_SA
#undef PG8_SB
#undef PG8_STAGE
#undef PG8_LDA
#undef PG8_LDB
#undef PG8_MMA
#undef PG8_WAIT_V
#undef PG8_WAIT_L
#undef PG8_BAR
#undef PG8_SCHED
}
}
constexpr int NWAVES = 8;
#ifndef MK_ONE_LAUNCH
#define MK_ONE_LAUNCH 1
#endif
constexpr int DM = 2048, DFF = 5632, DIN = 3072, NL = 4, DPLE = 256;
constexpr int MP = 8192, MS = 32, MV = MP + MS, MR = 8448;
constexpr int SEQ = 2048, NBATCH = 4;
constexpr float LN_EPS = 1e-5f, ALPHA = 1.6817928305074290f;
constexpr int ZU = 0, ZA = 512, ZG = 1024, ZQ = 1536, ZK = 2560, ZV = 2816;
constexpr size_t WGU1 = 0, WD1 = WGU1 + (size_t)2 * DFF * DM, WIN = WD1 + (size_t)DM * DFF, WOUT = WIN + (size_t)DIN * DM, WGU2 = WOUT + (size_t)DM * DM,
                 WD2 = WGU2 + (size_t)2 * DFF * DM, WPG = WD2 + (size_t)DM * DFF, WPLE = WPG + (size_t)DM * DM, WPOOL = WPLE + (size_t)DM * DPLE, WPW = WPOOL + 4 * 128 * 128,
                 WLAYER = WPW + 512 * 512;
constexpr size_t MiB = 1u << 20;
constexpr size_t WS_CTL = 0, CTL_ZERO_BYTES = 1 * MiB;
constexpr size_t WS_BIAS = 1 * MiB;
constexpr size_t WS_W = 2 * MiB;
constexpr size_t WS_H = 650 * MiB;
constexpr size_t WS_HB = 716 * MiB;
constexpr size_t WS_Y = 749 * MiB;
constexpr size_t WS_ACT = 815 * MiB;
constexpr size_t WS_Z = 906 * MiB;
constexpr size_t WS_MIN = 956 * MiB;
constexpr size_t WS_X = 989 * MiB;
constexpr size_t WS_C = 1006 * MiB;
constexpr size_t WS_VT = 1023 * MiB;
constexpr size_t WS_PB = 1027 * MiB;
constexpr size_t WS_END = 1044 * MiB;
static_assert(WS_W + 4 * WLAYER * 2 <= WS_H, "weights fit");
static_assert((size_t)MR * DM * 4 == 66 * MiB, "row buffers");
constexpr int CW_BAR = 4096;
constexpr size_t O_Y = 0, O_YS = O_Y + (size_t)MP * DM, O_KP = O_YS + (size_t)MS * DM, O_VP = O_KP + (size_t)NL * 4 * 128 * 256, O_PP = O_VP + (size_t)NL * 4 * 128 * 256,
                 O_CP = O_PP + (size_t)NL * 4 * 15 * 512, O_KS = O_CP + (size_t)NL * 4 * 30 * 512, O_VS = O_KS + (size_t)NL * 32 * 128 * 256, O_PS = O_VS + (size_t)NL * 32 * 128 * 256,
                 O_CS = O_PS + (size_t)NL * 32 * 15 * 512, O_END = O_CS + (size_t)NL * 32 * 30 * 512;
constexpr int RING_OFF = 0, RING_BYTES = 131072, LDSCTL_OFF = RING_BYTES, MISC_OFF = LDSCTL_OFF + 320, LDS_BYTES = 147456;

#define GAS __attribute__((address_space(1)))
#define LAS __attribute__((address_space(3)))
typedef unsigned short bf16;
typedef unsigned v4u __attribute__((ext_vector_type(4)));
typedef unsigned v2u __attribute__((ext_vector_type(2)));
typedef float f32x4 __attribute__((ext_vector_type(4)));
typedef short bf16x8 __attribute__((ext_vector_type(8)));
typedef GAS unsigned gu32;
#define RLX_AGENT __ATOMIC_RELAXED, __HIP_MEMORY_SCOPE_AGENT
#define LDS_WAIT() asm volatile("s_waitcnt lgkmcnt(0)" ::: "memory")
#define VM_WAIT() asm volatile("s_waitcnt vmcnt(0)" ::: "memory")
__device__ __forceinline__ unsigned f2bf(float f) { unsigned u = __builtin_bit_cast(unsigned, f); return (u + 0x7fffu + ((u >> 16) & 1u)) >> 16; }
__device__ __forceinline__ unsigned pk2(float lo, float hi) { return f2bf(lo) | (f2bf(hi) << 16); }
__device__ __forceinline__ float bf2f(unsigned short b) { return __uint_as_float((unsigned)b << 16); }
__device__ __forceinline__ float bflo(unsigned w) { return __uint_as_float(w << 16); }
__device__ __forceinline__ float bfhi(unsigned w) { return __uint_as_float(w & 0xffff0000u); }
__device__ __forceinline__ void unpack8(v4u v, float (&f)[8]) { f[0] = bflo(v.x); f[1] = bfhi(v.x); f[2] = bflo(v.y); f[3] = bfhi(v.y); f[4] = bflo(v.z); f[5] = bfhi(v.z); f[6] = bflo(v.w); f[7] = bfhi(v.w); }
__device__ __forceinline__ float sigm(float x) { return __builtin_amdgcn_rcpf(1.0f + __builtin_amdgcn_exp2f(-1.4426950408889634f * x)); }
__device__ __forceinline__ float wave_sum(float v) {
#pragma unroll
    for (int o = 1; o < 64; o <<= 1) v += __shfl_xor(v, o);
    return v;
}
__device__ __forceinline__ float wave_max(float v) {
#pragma unroll
    for (int o = 1; o < 64; o <<= 1) v = fmaxf(v, __shfl_xor(v, o));
    return v;
}
#define XB_TMO      128
#define XB_XCNT(j)  (256  + 64 * (j))
#define XB_XSUB(j)  (1280 + 64 * (j))
#define XB_XGEN(j)  (2304 + 64 * (j))
#define XB_TOP      3328
#define XB_TOPGEN   3392
#define XCD_BAR_WORDS 3456
#define XB_SPIN_CAP (1u << 18)

__device__ __forceinline__ unsigned xb_ld(unsigned* p)              { return __hip_atomic_load(p, __ATOMIC_RELAXED, __HIP_MEMORY_SCOPE_AGENT); }
__device__ __forceinline__ unsigned xb_add(unsigned* p, unsigned v) { return __hip_atomic_fetch_add(p, v, __ATOMIC_RELAXED, __HIP_MEMORY_SCOPE_AGENT); }
__device__ __forceinline__ unsigned xb_xcc_id() { return (unsigned)__builtin_amdgcn_s_getreg((3 << 11) | 20) & 0xFu; }
#define XB_SPIN(cond, bar) do { unsigned _sp = 0; while (cond) { __builtin_amdgcn_s_sleep(1); \
    if ((++_sp & 255u) == 0u) { if (xb_ld(&(bar)[XB_TMO])) break; if (_sp > XB_SPIN_CAP) { atomicAdd(&(bar)[XB_TMO], 1u); break; } } } } while (0)

struct XcdBarrier {
    unsigned* bar; unsigned x;
    volatile LAS unsigned* st;
};

__device__ __forceinline__ XcdBarrier xcd_barrier_post(unsigned* bar, volatile LAS unsigned* st) {
    XcdBarrier b; b.bar = bar; b.x = xb_xcc_id(); b.st = st;
    if (threadIdx.x == 0) (void)xb_add(&bar[XB_XCNT(b.x)], 1u);
    return b;
}
__device__ __forceinline__ void xcd_barrier_complete(unsigned* bar, unsigned x, unsigned& nloc, unsigned& nx) {
    const unsigned G = gridDim.x * gridDim.y * gridDim.z;
    unsigned sum, cnt, mine, sp = 0u;
    for (;;) {
        sum = 0u; cnt = 0u; mine = 0u;
#pragma unroll
        for (unsigned j = 0; j < 16; ++j) { const unsigned c = xb_ld(&bar[XB_XCNT(j)]); sum += c; cnt += (c > 0u) ? 1u : 0u; mine = (j == x) ? c : mine; }
        if (sum == G) break;
        __builtin_amdgcn_s_sleep(1);
        if ((++sp & 255u) == 0u) { if (xb_ld(&bar[XB_TMO])) break; if (sp > XB_SPIN_CAP) { atomicAdd(&bar[XB_TMO], 1u); break; } }
    }
    nloc = mine > 0u ? mine : 1u; nx = cnt > 0u ? cnt : 1u;
}

__device__ __forceinline__ void xcd_barrier(const XcdBarrier& b) {
    asm volatile("s_waitcnt vmcnt(0)" ::: "memory");
    __syncthreads();
    if (threadIdx.x == 0) {
        unsigned* bar = b.bar;
        __builtin_amdgcn_s_waitcnt(0);
        unsigned nloc = b.st[0], nx = b.st[1];
        if (nloc == 0u) { xcd_barrier_complete(bar, b.x, nloc, nx); b.st[0] = nloc; b.st[1] = nx; }
        const unsigned old = xb_add(&bar[XB_XSUB(b.x)], 1u);
        const unsigned gen = old / nloc;
        if (old + 1u == (gen + 1u) * nloc) {
            __builtin_amdgcn_fence(__ATOMIC_RELEASE, "agent");
            asm volatile("s_waitcnt vmcnt(0)" ::: "memory");
            const unsigned og = xb_add(&bar[XB_TOP], 1u);
            const unsigned tg = og / nx;
            if (og + 1u == (tg + 1u) * nx) xb_add(&bar[XB_TOPGEN], 1u);
            else XB_SPIN(xb_ld(&bar[XB_TOPGEN]) == tg, bar);
            __builtin_amdgcn_fence(__ATOMIC_ACQUIRE, "agent");
            xb_add(&bar[XB_XGEN(b.x)], 1u);
            asm volatile("s_waitcnt vmcnt(0)" ::: "memory");
        } else {
            XB_SPIN(xb_ld(&bar[XB_XGEN(b.x)]) == gen, bar);
            __builtin_amdgcn_fence(__ATOMIC_ACQUIRE, "agent");
            asm volatile("s_waitcnt vmcnt(0)" ::: "memory");
        }
    }
    __syncthreads();
}
enum InIdx { I_x_prompt = 0, I_x_sample, I_p_prompt, I_p_sample, I_cache_k, I_cache_v, I_state_pool, I_state_conv, I_rel_bias, I_ln1_g, I_ln1_b, I_w_gate1, I_w_up1, I_w_down1, I_w_in, I_w_pool, I_pool_scale,
    I_w_dw, I_b_dw, I_conv_ln_g, I_conv_ln_b, I_w_pw, I_sinks, I_w_out, I_ln2_g, I_ln2_b, I_w_gate2, I_w_up2, I_w_down2, I_ln3_g, I_ln3_b, I_w_pg, I_w_ple };
__device__ __forceinline__ const float* ld_arg(int i) {
    const __attribute__((address_space(4))) char* ka = (const __attribute__((address_space(4))) char*)__builtin_amdgcn_kernarg_segment_ptr();
    asm volatile("" : "+s"(ka));
    return *(const float* const __attribute__((address_space(4)))*)(ka + 8 * i);
}
__device__ __forceinline__ unsigned char* ld_ws() { return (unsigned char*)ld_arg(34); }
__device__ __forceinline__ float* ld_out() { return (float*)ld_arg(33); }
__device__ __forceinline__ int ld_argi(int byte_off) {
    const __attribute__((address_space(4))) char* ka = (const __attribute__((address_space(4))) char*)__builtin_amdgcn_kernarg_segment_ptr();
    asm volatile("" : "+s"(ka));
    return *(const int __attribute__((address_space(4)))*)(ka + byte_off);
}
struct Frame {
    LAS unsigned char* lds;
    int tid, lane, wave;
    __device__ __forceinline__ float* biasT() const { return (float*)(ld_ws() + WS_BIAS); }
    __device__ __forceinline__ bf16* W() const { return (bf16*)(ld_ws() + WS_W); }
    __device__ __forceinline__ float* H() const { return (float*)(ld_ws() + WS_H); }
    __device__ __forceinline__ bf16* HB() const { return (bf16*)(ld_ws() + WS_HB); }
    __device__ __forceinline__ float* Y() const { return (float*)(ld_ws() + WS_Y); }
    __device__ __forceinline__ bf16* ACT() const { return (bf16*)(ld_ws() + WS_ACT); }
    __device__ __forceinline__ float* Y2() const { return (float*)(ld_ws() + WS_ACT); }
    __device__ __forceinline__ bf16* Z() const { return (bf16*)(ld_ws() + WS_Z); }
    __device__ __forceinline__ bf16* MIN() const { return (bf16*)(ld_ws() + WS_MIN); }
    __device__ __forceinline__ bf16* X() const { return (bf16*)(ld_ws() + WS_X); }
    __device__ __forceinline__ float* C() const { return (float*)(ld_ws() + WS_C); }
    __device__ __forceinline__ bf16* VT() const { return (bf16*)(ld_ws() + WS_VT); }
    __device__ __forceinline__ bf16* PB() const { return (bf16*)(ld_ws() + WS_PB); }
};

#define FRAME_LOCAL(F, F0) Frame F = F0; asm volatile("" : "+v"(F.lane), "+v"(F.tid), "+s"(F.wave))
__device__ __forceinline__ void transpose_item(const float* W, int K, int N, bf16* WT, int mode, LAS float* scr, int item, int lane) {
    const int nblk = N / 32, kb = item / nblk, nb = item % nblk, k0 = 64 * kb, n0 = 32 * nb;
    const int drow0 = mode == 0 ? n0 : (256 * (n0 >> 7) + (n0 & 127) + (mode == 2 ? 128 : 0));
#pragma unroll 8
    for (int i = 0; i < 32; ++i) { const int kk = 2 * i + (lane >> 5); scr[kk * 33 + (lane & 31)] = W[(size_t)(k0 + kk) * N + n0 + (lane & 31)]; }
    LDS_WAIT(); asm volatile("" ::: "memory");
    const int c = lane & 7;
#pragma unroll
    for (int j = 0; j < 4; ++j) { const int n = (lane >> 3) + 8 * j; const LAS float* s = scr + (8 * c) * 33 + n;
        v4u o; o.x = pk2(s[0 * 33], s[1 * 33]); o.y = pk2(s[2 * 33], s[3 * 33]); o.z = pk2(s[4 * 33], s[5 * 33]); o.w = pk2(s[6 * 33], s[7 * 33]);
        *(GAS v4u*)(WT + (size_t)(drow0 + n) * K + k0 + 8 * c) = o; }
    LDS_WAIT(); asm volatile("" ::: "memory");
}
__device__ __forceinline__ int t5_bucket(int n) {
    if (n < 16) return n;
    const int lb = 16 + (int)(__logf((float)n * (1.0f / 16.0f)) * (16.0f / 2.0794415416798357f));
    return lb < 31 ? lb : 31;
}
__device__ __forceinline__ void p0_prologue(Frame& F0) {
    FRAME_LOCAL(F, F0);
    LAS float* scr = (LAS float*)(F.lds + RING_OFF + F.wave * 16384);
    constexpr int I_GU = (DM / 64) * (DFF / 32), I_D = (DFF / 64) * (DM / 32), I_IN = (DM / 64) * (DIN / 32), I_SQ = (DM / 64) * (DM / 32), I_PLE = (DPLE / 64) * (DM / 32), I_POOL = 4 * 2 * 4, I_PW = 8 * 16;
    constexpr int I_LAYER = 4 * I_GU + 2 * I_D + I_IN + 2 * I_SQ + I_PLE + I_POOL + I_PW;
    bf16* Wp = F.W();
    for (int it = (int)(blockIdx.x * NWAVES + F.wave); it < NL * I_LAYER; it += (int)(gridDim.x * NWAVES)) {
        const int l = it / I_LAYER; int r = it % I_LAYER;
        bf16* Wl = Wp + (size_t)l * WLAYER;
        if (r < I_GU) { transpose_item(ld_arg(I_w_gate1) + (size_t)l * DM * DFF, DM, DFF, Wl + WGU1, 1, scr, r, F.lane); continue; } r -= I_GU;
        if (r < I_GU) { transpose_item(ld_arg(I_w_up1) + (size_t)l * DM * DFF, DM, DFF, Wl + WGU1, 2, scr, r, F.lane); continue; } r -= I_GU;
        if (r < I_D) { transpose_item(ld_arg(I_w_down1) + (size_t)l * DM * DFF, DFF, DM, Wl + WD1, 0, scr, r, F.lane); continue; } r -= I_D;
        if (r < I_IN) { transpose_item(ld_arg(I_w_in) + (size_t)l * DM * DIN, DM, DIN, Wl + WIN, 0, scr, r, F.lane); continue; } r -= I_IN;
        if (r < I_SQ) { transpose_item(ld_arg(I_w_out) + (size_t)l * DM * DM, DM, DM, Wl + WOUT, 0, scr, r, F.lane); continue; } r -= I_SQ;
        if (r < I_GU) { transpose_item(ld_arg(I_w_gate2) + (size_t)l * DM * DFF, DM, DFF, Wl + WGU2, 1, scr, r, F.lane); continue; } r -= I_GU;
        if (r < I_GU) { transpose_item(ld_arg(I_w_up2) + (size_t)l * DM * DFF, DM, DFF, Wl + WGU2, 2, scr, r, F.lane); continue; } r -= I_GU;
        if (r < I_D) { transpose_item(ld_arg(I_w_down2) + (size_t)l * DM * DFF, DFF, DM, Wl + WD2, 0, scr, r, F.lane); continue; } r -= I_D;
        if (r < I_SQ) { transpose_item(ld_arg(I_w_pg) + (size_t)l * DM * DM, DM, DM, Wl + WPG, 0, scr, r, F.lane); continue; } r -= I_SQ;
        if (r < I_PLE) { transpose_item(ld_arg(I_w_ple) + (size_t)l * DPLE * DM, DPLE, DM, Wl + WPLE, 0, scr, r, F.lane); continue; } r -= I_PLE;
        if (r < I_POOL) { const int g = r >> 3; transpose_item(ld_arg(I_w_pool) + (size_t)(l * 4 + g) * 128 * 128, 128, 128, Wl + WPOOL + (size_t)g * 128 * 128, 0, scr, r & 7, F.lane); continue; } r -= I_POOL;
        transpose_item(ld_arg(I_w_pw) + (size_t)l * 512 * 512, 512, 512, Wl + WPW, 0, scr, r, F.lane);
    }
    float* Hp = F.H(); bf16* HBp = F.HB(); bf16* PBp = F.PB(); float* biasTp = F.biasT();
    const float* x_prompt = ld_arg(I_x_prompt); const float* x_sample = ld_arg(I_x_sample); const float* p_prompt = ld_arg(I_p_prompt); const float* p_sample = ld_arg(I_p_sample); const float* rel_bias = ld_arg(I_rel_bias);
    for (int r = (int)(blockIdx.x * NWAVES + F.wave); r < MR; r += (int)(gridDim.x * NWAVES)) {
        const float* src = r < MP ? x_prompt + (size_t)r * DM : (r < MV ? x_sample + (size_t)(r - MP) * DM : nullptr);
        GAS f32x4* ho = (GAS f32x4*)(Hp + (size_t)r * DM) + F.lane; GAS v2u* bo = (GAS v2u*)(HBp + (size_t)r * DM) + F.lane;
#pragma unroll
        for (int j = 0; j < 8; ++j) { f32x4 v = src ? ((const GAS f32x4*)src)[F.lane + 64 * j] : (f32x4){0.f, 0.f, 0.f, 0.f};
            ho[64 * j] = v; v2u o; o.x = pk2(v.x, v.y); o.y = pk2(v.z, v.w); bo[64 * j] = o; }
    }
    for (int i = (int)(blockIdx.x * NWAVES + F.wave); i < NL * MR; i += (int)(gridDim.x * NWAVES)) {
        const int l = i / MR, r = i % MR;
        const float* src = r < MP ? p_prompt + ((size_t)l * MP + r) * DPLE : (r < MV ? p_sample + ((size_t)l * MS + (r - MP)) * DPLE : nullptr);
        f32x4 v = src ? ((const GAS f32x4*)src)[F.lane] : (f32x4){0.f, 0.f, 0.f, 0.f};
        v2u o; o.x = pk2(v.x, v.y); o.y = pk2(v.z, v.w); ((GAS v2u*)(PBp + (size_t)i * DPLE))[F.lane] = o;
    }
    { const int gt = blockIdx.x * (NWAVES * 64) + F.tid;
      if (gt < 16 * 128) { const int h = gt >> 7, dist = gt & 127; biasTp[gt] = rel_bias[t5_bucket(dist) * 16 + h]; } }
}

__device__ __forceinline__ void ln_pass(Frame& F0, float coef, const float* g, const float* b) {
    FRAME_LOCAL(F, F0);
    float* Hp = F.H(); const float* Yp = F.Y(); bf16* HBp = F.HB();
    for (int r = (int)(blockIdx.x * NWAVES + F.wave); r < MV; r += (int)(gridDim.x * NWAVES)) {
        GAS f32x4* hp = (GAS f32x4*)(Hp + (size_t)r * DM) + F.lane; const GAS f32x4* yp = (const GAS f32x4*)(Yp + (size_t)r * DM) + F.lane;
        f32x4 v[8]; float s = 0.f;
#pragma unroll
        for (int j = 0; j < 8; ++j) { const f32x4 h = hp[64 * j], y = yp[64 * j]; v[j] = h * ALPHA + y * coef; s += (v[j].x + v[j].y) + (v[j].z + v[j].w); }
        const float mean = wave_sum(s) * (1.f / DM); float s2 = 0.f;
#pragma unroll
        for (int j = 0; j < 8; ++j) { v[j] = v[j] - mean; s2 += (v[j].x * v[j].x + v[j].y * v[j].y) + (v[j].z * v[j].z + v[j].w * v[j].w); }
        const float rstd = 1.f / sqrtf(wave_sum(s2) * (1.f / DM) + LN_EPS);
        GAS v2u* bo = (GAS v2u*)(HBp + (size_t)r * DM) + F.lane;
#pragma unroll
        for (int j = 0; j < 8; ++j) { const f32x4 gg = ((const GAS f32x4*)g)[F.lane + 64 * j], bb = ((const GAS f32x4*)b)[F.lane + 64 * j];
            const f32x4 o = v[j] * rstd * gg + bb; hp[64 * j] = o; v2u w; w.x = pk2(o.x, o.y); w.y = pk2(o.z, o.w); bo[64 * j] = w; }
    }
}

__device__ __forceinline__ void mix0(Frame& F0) {
    FRAME_LOCAL(F, F0);
    const bf16* Zp = F.Z(); float* Cp = F.C(); bf16* VTp = F.VT();
    for (int r = (int)(blockIdx.x * NWAVES + F.wave); r < MV; r += (int)(gridDim.x * NWAVES)) {
        const bf16* zr = Zp + (size_t)r * DIN; float a[8], g[8];
        unpack8(*(const GAS v4u*)(zr + ZA + F.lane * 8), a); unpack8(*(const GAS v4u*)(zr + ZG + F.lane * 8), g);
        f32x4 c0, c1; c0.x = a[0] * sigm(g[0]); c0.y = a[1] * sigm(g[1]); c0.z = a[2] * sigm(g[2]); c0.w = a[3] * sigm(g[3]);
        c1.x = a[4] * sigm(g[4]); c1.y = a[5] * sigm(g[5]); c1.z = a[6] * sigm(g[6]); c1.w = a[7] * sigm(g[7]);
        GAS f32x4* cp = (GAS f32x4*)(Cp + (size_t)r * 512 + F.lane * 8); cp[0] = c0; cp[1] = c1;
    }
    for (int t = (int)(blockIdx.x * NWAVES + F.wave); t < 4 * 4 * 32; t += (int)(gridDim.x * NWAVES)) {
        const int ch = t & 31, kvh = (t >> 5) & 3, b = t >> 7, tok = ch * 64 + F.lane;
        const bf16* zr = Zp + (size_t)(b * SEQ + tok) * DIN + ZV + kvh * 64; bf16* vt = VTp + (size_t)((b * 4 + kvh) * 64) * SEQ + tok;
#pragma unroll
        for (int dc = 0; dc < 8; ++dc) { const v4u v = *(const GAS v4u*)(zr + dc * 8);
            vt[(size_t)(dc * 8 + 0) * SEQ] = (bf16)(v.x & 0xffffu); vt[(size_t)(dc * 8 + 1) * SEQ] = (bf16)(v.x >> 16);
            vt[(size_t)(dc * 8 + 2) * SEQ] = (bf16)(v.y & 0xffffu); vt[(size_t)(dc * 8 + 3) * SEQ] = (bf16)(v.y >> 16);
            vt[(size_t)(dc * 8 + 4) * SEQ] = (bf16)(v.z & 0xffffu); vt[(size_t)(dc * 8 + 5) * SEQ] = (bf16)(v.z >> 16);
            vt[(size_t)(dc * 8 + 6) * SEQ] = (bf16)(v.w & 0xffffu); vt[(size_t)(dc * 8 + 7) * SEQ] = (bf16)(v.w >> 16); }
    }
}

__device__ __forceinline__ void mix1(Frame& F0, int l) {
    FRAME_LOCAL(F, F0);
    const int ch = F.lane * 8, grp = F.lane >> 4, w = 2 << grp;
    const float* state_pool = ld_arg(I_state_pool); const float* state_conv = ld_arg(I_state_conv); const float* b_dw = ld_arg(I_b_dw); const float* w_dw = ld_arg(I_w_dw); const float* conv_ln_g = ld_arg(I_conv_ln_g); const float* conv_ln_b = ld_arg(I_conv_ln_b);
    const bf16* Zp = F.Z(); bf16* Xp = F.X(); const float* Cp = F.C();
    for (int r = (int)(blockIdx.x * NWAVES + F.wave); r < MV; r += (int)(gridDim.x * NWAVES)) {
        const bool smp = r >= MP; const int b = smp ? r - MP : r / SEQ, t = smp ? 0 : r % SEQ;
        float cur[8], sum[8];
        unpack8(*(const GAS v4u*)(Zp + (size_t)r * DIN + ZU + ch), cur);
#pragma unroll
        for (int j = 0; j < 8; ++j) sum[j] = cur[j];
        for (int i = 1; i < 16; ++i) {
            if (i < w) {
                if (!smp) { if (t - i >= 0) { float u[8]; unpack8(*(const GAS v4u*)(Zp + (size_t)(r - i) * DIN + ZU + ch), u);
#pragma unroll
                        for (int j = 0; j < 8; ++j) sum[j] += u[j]; } }
                else { const GAS f32x4* sp = (const GAS f32x4*)(state_pool + ((size_t)(l * MS + b) * 15 + (15 - i)) * 512 + ch); const f32x4 u0 = sp[0], u1 = sp[1];
                    sum[0] += u0.x; sum[1] += u0.y; sum[2] += u0.z; sum[3] += u0.w; sum[4] += u1.x; sum[5] += u1.y; sum[6] += u1.z; sum[7] += u1.w; }
            }
        }
        { const int cnt = smp ? w : ((t + 1) < w ? (t + 1) : w); const float inv = 1.0f / (float)cnt;
          v4u o; o.x = pk2(sum[0] * inv - cur[0], sum[1] * inv - cur[1]); o.y = pk2(sum[2] * inv - cur[2], sum[3] * inv - cur[3]);
          o.z = pk2(sum[4] * inv - cur[4], sum[5] * inv - cur[5]); o.w = pk2(sum[6] * inv - cur[6], sum[7] * inv - cur[7]);
          *(GAS v4u*)(Xp + (size_t)r * 1024 + ch) = o; }
        float acc[8];
        { const GAS f32x4* bp = (const GAS f32x4*)(b_dw + (size_t)l * 512 + ch); const f32x4 b0 = bp[0], b1 = bp[1];
          acc[0] = b0.x; acc[1] = b0.y; acc[2] = b0.z; acc[3] = b0.w; acc[4] = b1.x; acc[5] = b1.y; acc[6] = b1.z; acc[7] = b1.w; }
        for (int j = 0; j < 31; ++j) {
            const float* src;
            if (!smp) { const int tt = t - 30 + j; if (tt < 0) continue; src = Cp + (size_t)(r - 30 + j) * 512 + ch; }
            else src = (j == 30) ? Cp + (size_t)r * 512 + ch : state_conv + ((size_t)(l * MS + b) * 30 + j) * 512 + ch;
            const f32x4 c0 = ((const GAS f32x4*)src)[0], c1 = ((const GAS f32x4*)src)[1];
            const GAS f32x4* wp = (const GAS f32x4*)(w_dw + ((size_t)l * 31 + j) * 512 + ch); const f32x4 w0 = wp[0], w1 = wp[1];
            acc[0] += c0.x * w0.x; acc[1] += c0.y * w0.y; acc[2] += c0.z * w0.z; acc[3] += c0.w * w0.w;
            acc[4] += c1.x * w1.x; acc[5] += c1.y * w1.y; acc[6] += c1.z * w1.z; acc[7] += c1.w * w1.w;
        }
        float s = 0.f;
#pragma unroll
        for (int j = 0; j < 8; ++j) s += acc[j];
        const float mean = wave_sum(s) * (1.f / 512.f); float s2 = 0.f;
#pragma unroll
        for (int j = 0; j < 8; ++j) { acc[j] -= mean; s2 += acc[j] * acc[j]; }
        const float rstd = 1.f / sqrtf(wave_sum(s2) * (1.f / 512.f) + LN_EPS);
        { const GAS f32x4* gp = (const GAS f32x4*)(conv_ln_g + (size_t)l * 512 + ch); const GAS f32x4* bp = (const GAS f32x4*)(conv_ln_b + (size_t)l * 512 + ch);
          const f32x4 g0 = gp[0], g1 = gp[1], b0 = bp[0], b1 = bp[1]; float y[8];
          y[0] = acc[0] * rstd * g0.x + b0.x; y[1] = acc[1] * rstd * g0.y + b0.y; y[2] = acc[2] * rstd * g0.z + b0.z; y[3] = acc[3] * rstd * g0.w + b0.w;
          y[4] = acc[4] * rstd * g1.x + b1.x; y[5] = acc[5] * rstd * g1.y + b1.y; y[6] = acc[6] * rstd * g1.z + b1.z; y[7] = acc[7] * rstd * g1.w + b1.w;
#pragma unroll
          for (int j = 0; j < 8; ++j) y[j] = y[j] * sigm(y[j]);
          v4u o; o.x = pk2(y[0], y[1]); o.y = pk2(y[2], y[3]); o.z = pk2(y[4], y[5]); o.w = pk2(y[6], y[7]);
          *(GAS v4u*)(Xp + (size_t)r * 1024 + 512 + ch) = o; }
    }
}

#define MFMA16(a, b, c) __builtin_amdgcn_mfma_f32_16x16x32_bf16((a), (b), (c), 0, 0, 0)
__device__ __forceinline__ void wave_gemm_32x64(const bf16* A, int lda, const bf16* Bt, int ldb, int K, int lane, f32x4 (&acc)[2][4]) {
    const int fr = lane & 15, fq = lane >> 4;
#pragma unroll
    for (int mi = 0; mi < 2; ++mi)
#pragma unroll
        for (int ni = 0; ni < 4; ++ni) acc[mi][ni] = (f32x4){0.f, 0.f, 0.f, 0.f};
    const bf16* ap = A + (size_t)fr * lda + fq * 8; const bf16* bp = Bt + (size_t)fr * ldb + fq * 8;
    for (int k0 = 0; k0 < K; k0 += 32) {
        bf16x8 a[2], b[4];
#pragma unroll
        for (int mi = 0; mi < 2; ++mi) a[mi] = *(const GAS bf16x8*)(ap + (size_t)mi * 16 * lda + k0);
#pragma unroll
        for (int ni = 0; ni < 4; ++ni) b[ni] = *(const GAS bf16x8*)(bp + (size_t)ni * 16 * ldb + k0);
#pragma unroll
        for (int mi = 0; mi < 2; ++mi)
#pragma unroll
            for (int ni = 0; ni < 4; ++ni) acc[mi][ni] = MFMA16(b[ni], a[mi], acc[mi][ni]);
    }
}
__device__ __forceinline__ void attn_prompt_task(Frame& F, int l, int task, const float* sinks) {
    const int qt = task & 127, h = (task >> 7) & 15, b = task >> 11, kvh = h >> 2;
    const int fr = F.lane & 15, fq = F.lane >> 4, t0 = qt * 16;
    const bf16* zb = F.Z() + (size_t)(b * SEQ) * DIN;
    bf16x8 qf[2];
#pragma unroll
    for (int ks = 0; ks < 2; ++ks) qf[ks] = *(const GAS bf16x8*)(zb + (size_t)(t0 + fr) * DIN + ZQ + h * 64 + ks * 32 + fq * 8);
    f32x4 s[10];
#pragma unroll
    for (int kt = 0; kt < 10; ++kt) {
        int key = t0 - 128 + kt * 16 + fr; key = key < 0 ? 0 : (key > SEQ - 1 ? SEQ - 1 : key);
        const bf16* kp = zb + (size_t)key * DIN + ZK + kvh * 64 + fq * 8;
        const bf16x8 k0 = *(const GAS bf16x8*)kp, k1 = *(const GAS bf16x8*)(kp + 32);
        f32x4 a = (f32x4){0.f, 0.f, 0.f, 0.f};
        a = MFMA16(k0, qf[0], a); a = MFMA16(k1, qf[1], a); s[kt] = a;
    }
    const float sink = sinks[l * 16 + h]; const float* bt = F.biasT() + h * 128;
    float m = sink;
#pragma unroll
    for (int kt = 0; kt < 10; ++kt)
#pragma unroll
        for (int r = 0; r < 4; ++r) { const int key = t0 - 128 + kt * 16 + fq * 4 + r, dist = t0 + fr - key; const bool valid = (dist >= 0) && (dist < 128) && (key >= 0);
            const float v = valid ? s[kt][r] * 0.125f + bt[dist & 127] : -1e30f; s[kt][r] = v; m = fmaxf(m, v); }
    m = fmaxf(m, __shfl_xor(m, 16)); m = fmaxf(m, __shfl_xor(m, 32));
    float sum = 0.f;
#pragma unroll
    for (int kt = 0; kt < 10; ++kt)
#pragma unroll
        for (int r = 0; r < 4; ++r) { const float e = __expf(s[kt][r] - m); s[kt][r] = e; sum += e; }
    sum += __shfl_xor(sum, 16); sum += __shfl_xor(sum, 32);
    sum += __expf(sink - m);
    const float inv = 1.0f / sum;
    f32x4 o[4];
#pragma unroll
    for (int dt = 0; dt < 4; ++dt) o[dt] = (f32x4){0.f, 0.f, 0.f, 0.f};
    const bf16* vt = F.VT() + (size_t)((b * 4 + kvh) * 64) * SEQ;
#pragma unroll
    for (int i = 0; i < 5; ++i) {
        v4u pw; pw.x = pk2(s[2 * i][0] * inv, s[2 * i][1] * inv); pw.y = pk2(s[2 * i][2] * inv, s[2 * i][3] * inv);
        pw.z = pk2(s[2 * i + 1][0] * inv, s[2 * i + 1][1] * inv); pw.w = pk2(s[2 * i + 1][2] * inv, s[2 * i + 1][3] * inv);
        const bf16x8 pb = __builtin_bit_cast(bf16x8, pw);
        int ka = t0 - 128 + 32 * i + 4 * fq, kb = ka + 16;
        ka = ka < 0 ? 0 : (ka > SEQ - 4 ? SEQ - 4 : ka); kb = kb < 0 ? 0 : (kb > SEQ - 4 ? SEQ - 4 : kb);
#pragma unroll
        for (int dt = 0; dt < 4; ++dt) { const bf16* vp = vt + (size_t)(dt * 16 + fr) * SEQ;
            const v2u va = *(const GAS v2u*)(vp + ka), vb = *(const GAS v2u*)(vp + kb);
            v4u vw; vw.x = va.x; vw.y = va.y; vw.z = vb.x; vw.w = vb.y;
            o[dt] = MFMA16(__builtin_bit_cast(bf16x8, vw), pb, o[dt]); }
    }
    bf16* op = F.MIN() + (size_t)(b * SEQ + t0 + fr) * DM + 1024 + h * 64 + 4 * fq;
#pragma unroll
    for (int dt = 0; dt < 4; ++dt) { v2u w; w.x = pk2(o[dt][0], o[dt][1]); w.y = pk2(o[dt][2], o[dt][3]); *(GAS v2u*)(op + dt * 16) = w; }
}
__device__ __forceinline__ void attn_sample_task(Frame& F, int l, int task, LAS float* scr, const float* sinks, const float* cache_k, const float* cache_v) {
    const int b = task >> 4, h = task & 15, kvh = h >> 2, row = MP + b, lane = F.lane;
    const bf16* zr = F.Z() + (size_t)row * DIN;
    const float qd = bf2f(zr[ZQ + h * 64 + lane]);
    scr[lane] = qd; LDS_WAIT();
    const float* ck = cache_k + ((size_t)(l * MS + b) * 128 * 4 + kvh) * 64; const float* cv = cache_v + ((size_t)(l * MS + b) * 128 * 4 + kvh) * 64;
    float s0 = 0.f, s1 = 0.f;
#pragma unroll 4
    for (int d4 = 0; d4 < 16; ++d4) { const f32x4 q4 = *(const LAS f32x4*)(scr + 4 * d4);
        const f32x4 a = *(const GAS f32x4*)(ck + (size_t)lane * 256 + 4 * d4), c = *(const GAS f32x4*)(ck + (size_t)(lane + 64) * 256 + 4 * d4);
        s0 += q4.x * a.x + q4.y * a.y + q4.z * a.z + q4.w * a.w; s1 += q4.x * c.x + q4.y * c.y + q4.z * c.z + q4.w * c.w; }
    const float sn = wave_sum(qd * bf2f(zr[ZK + kvh * 64 + lane]));
    const float sink = sinks[l * 16 + h]; const float* bt = F.biasT() + h * 128;
    const float v0 = lane >= 1 ? s0 * 0.125f + bt[(128 - lane) & 127] : -1e30f, v1 = s1 * 0.125f + bt[64 - lane], vn = sn * 0.125f + bt[0];
    const float m = fmaxf(fmaxf(wave_max(fmaxf(v0, v1)), vn), sink);
    const float e0 = __expf(v0 - m), e1 = __expf(v1 - m), en = __expf(vn - m);
    const float inv = 1.0f / (wave_sum(e0 + e1) + en + __expf(sink - m));
    LDS_WAIT();
    scr[64 + lane] = e0 * inv; scr[128 + lane] = e1 * inv; LDS_WAIT();
    float o = en * inv * bf2f(zr[ZV + kvh * 64 + lane]);
#pragma unroll 8
    for (int j = 0; j < 128; ++j) o += scr[64 + j] * cv[(size_t)j * 256 + lane];
    F.MIN()[(size_t)row * DM + 1024 + h * 64 + lane] = (bf16)f2bf(o);
    LDS_WAIT();
}
__device__ __forceinline__ void mix2(Frame& F0, int l) {
    FRAME_LOCAL(F, F0);
    const bf16* Wl = F.W() + (size_t)l * WLAYER; const int lane = F.lane, fr = lane & 15, fq = lane >> 4;
    const bf16* Zp = F.Z(); const bf16* Xp = F.X(); bf16* MINp = F.MIN(); const float* Cp = F.C();
    float* outp = ld_out();
    const float* pool_scale = ld_arg(I_pool_scale); const float* sinks = ld_arg(I_sinks); const float* cache_k = ld_arg(I_cache_k); const float* cache_v = ld_arg(I_cache_v); const float* state_pool = ld_arg(I_state_pool); const float* state_conv = ld_arg(I_state_conv);
    for (int t = (int)(blockIdx.x * NWAVES + F.wave); t < 257 * 8; t += (int)(gridDim.x * NWAVES)) { const int rt = t >> 3, ct = t & 7; f32x4 acc[2][4];
        wave_gemm_32x64(Xp + (size_t)rt * 32 * 1024 + 512, 1024, Wl + WPW + (size_t)ct * 64 * 512, 512, 512, lane, acc);
#pragma unroll
        for (int mi = 0; mi < 2; ++mi)
#pragma unroll
            for (int ni = 0; ni < 4; ++ni) { v2u w; w.x = pk2(acc[mi][ni][0], acc[mi][ni][1]); w.y = pk2(acc[mi][ni][2], acc[mi][ni][3]);
                *(GAS v2u*)(MINp + (size_t)(rt * 32 + mi * 16 + fr) * DM + 512 + ct * 64 + ni * 16 + 4 * fq) = w; } }
    for (int t = (int)(blockIdx.x * NWAVES + F.wave); t < 257 * 8; t += (int)(gridDim.x * NWAVES)) { const int rt = t >> 3, g = (t >> 1) & 3, ct = t & 1; f32x4 acc[2][4];
        wave_gemm_32x64(Xp + (size_t)rt * 32 * 1024 + g * 128, 1024, Wl + WPOOL + (size_t)(g * 128 + ct * 64) * 128, 128, 128, lane, acc);
#pragma unroll
        for (int ni = 0; ni < 4; ++ni) { const int col = g * 128 + ct * 64 + ni * 16 + 4 * fq; const f32x4 sc = *(const GAS f32x4*)(pool_scale + (size_t)l * 512 + col);
#pragma unroll
            for (int mi = 0; mi < 2; ++mi) { const f32x4 v = acc[mi][ni] * sc; v2u w; w.x = pk2(v[0], v[1]); w.y = pk2(v[2], v[3]);
                *(GAS v2u*)(MINp + (size_t)(rt * 32 + mi * 16 + fr) * DM + col) = w; } } }
    for (int t = (int)(blockIdx.x * NWAVES + F.wave); t < NBATCH * 16 * 128; t += (int)(gridDim.x * NWAVES)) attn_prompt_task(F, l, t, sinks);
    { LAS float* scr = (LAS float*)(F.lds + RING_OFF + F.wave * 1024);
      for (int t = (int)(blockIdx.x * NWAVES + F.wave); t < MS * 16; t += (int)(gridDim.x * NWAVES)) attn_sample_task(F, l, t, scr, sinks, cache_k, cache_v); }
    for (int t = (int)(blockIdx.x * NWAVES + F.wave); t < NBATCH * 128; t += (int)(gridDim.x * NWAVES)) { const int b = t >> 7, j = t & 127; float v[8];
        unpack8(*(const GAS v4u*)(Zp + (size_t)(b * SEQ + SEQ - 128 + j) * DIN + ZK + lane * 8), v);
        float* dst = outp + (lane < 32 ? O_KP : O_VP) + ((size_t)(l * NBATCH + b) * 128 + j) * 256 + (lane & 31) * 8;
        ((GAS f32x4*)dst)[0] = (f32x4){v[0], v[1], v[2], v[3]}; ((GAS f32x4*)dst)[1] = (f32x4){v[4], v[5], v[6], v[7]}; }
    for (int t = (int)(blockIdx.x * NWAVES + F.wave); t < NBATCH * 15; t += (int)(gridDim.x * NWAVES)) { const int b = t / 15, i = t % 15; float v[8];
        unpack8(*(const GAS v4u*)(Zp + (size_t)(b * SEQ + SEQ - 15 + i) * DIN + ZU + lane * 8), v);
        float* dst = outp + O_PP + ((size_t)(l * NBATCH + b) * 15 + i) * 512 + lane * 8;
        ((GAS f32x4*)dst)[0] = (f32x4){v[0], v[1], v[2], v[3]}; ((GAS f32x4*)dst)[1] = (f32x4){v[4], v[5], v[6], v[7]}; }
    for (int t = (int)(blockIdx.x * NWAVES + F.wave); t < NBATCH * 30; t += (int)(gridDim.x * NWAVES)) { const int b = t / 30, i = t % 30;
        const GAS f32x4* src = (const GAS f32x4*)(Cp + (size_t)(b * SEQ + SEQ - 30 + i) * 512 + lane * 8);
        float* dst = outp + O_CP + ((size_t)(l * NBATCH + b) * 30 + i) * 512 + lane * 8;
        ((GAS f32x4*)dst)[0] = src[0]; ((GAS f32x4*)dst)[1] = src[1]; }
    for (int t = (int)(blockIdx.x * NWAVES + F.wave); t < MS * 128; t += (int)(gridDim.x * NWAVES)) { const int b = t >> 7, j = t & 127;
        float* dk = outp + O_KS + ((size_t)(l * MS + b) * 128 + j) * 256 + lane * 4; float* dv = outp + O_VS + ((size_t)(l * MS + b) * 128 + j) * 256 + lane * 4;
        if (j < 127) { *(GAS f32x4*)dk = *(const GAS f32x4*)(cache_k + ((size_t)(l * MS + b) * 128 + j + 1) * 256 + lane * 4);
                       *(GAS f32x4*)dv = *(const GAS f32x4*)(cache_v + ((size_t)(l * MS + b) * 128 + j + 1) * 256 + lane * 4); }
        else { const bf16* zr = Zp + (size_t)(MP + b) * DIN; const v2u kk = *(const GAS v2u*)(zr + ZK + lane * 4), vv = *(const GAS v2u*)(zr + ZV + lane * 4);
               *(GAS f32x4*)dk = (f32x4){bflo(kk.x), bfhi(kk.x), bflo(kk.y), bfhi(kk.y)}; *(GAS f32x4*)dv = (f32x4){bflo(vv.x), bfhi(vv.x), bflo(vv.y), bfhi(vv.y)}; } }
    for (int t = (int)(blockIdx.x * NWAVES + F.wave); t < MS * 15; t += (int)(gridDim.x * NWAVES)) { const int b = t / 15, i = t % 15; float* dst = outp + O_PS + ((size_t)(l * MS + b) * 15 + i) * 512 + lane * 8;
        if (i < 14) { const GAS f32x4* src = (const GAS f32x4*)(state_pool + ((size_t)(l * MS + b) * 15 + i + 1) * 512 + lane * 8); ((GAS f32x4*)dst)[0] = src[0]; ((GAS f32x4*)dst)[1] = src[1]; }
        else { float v[8]; unpack8(*(const GAS v4u*)(Zp + (size_t)(MP + b) * DIN + ZU + lane * 8), v);
               ((GAS f32x4*)dst)[0] = (f32x4){v[0], v[1], v[2], v[3]}; ((GAS f32x4*)dst)[1] = (f32x4){v[4], v[5], v[6], v[7]}; } }
    for (int t = (int)(blockIdx.x * NWAVES + F.wave); t < MS * 30; t += (int)(gridDim.x * NWAVES)) { const int b = t / 30, i = t % 30; float* dst = outp + O_CS + ((size_t)(l * MS + b) * 30 + i) * 512 + lane * 8;
        const GAS f32x4* src = (const GAS f32x4*)((i < 29 ? state_conv + ((size_t)(l * MS + b) * 30 + i + 1) * 512 : Cp + (size_t)(MP + b) * 512) + lane * 8);
        ((GAS f32x4*)dst)[0] = src[0]; ((GAS f32x4*)dst)[1] = src[1]; }
}

__device__ __forceinline__ void ple_pass(Frame& F0, int l) {
    FRAME_LOCAL(F, F0);
    float* outp = ld_out(); float* Hp = F.H(); const float* Yp = F.Y(); const float* Y2p = F.Y2(); bf16* HBp = F.HB();
    for (int r = (int)(blockIdx.x * NWAVES + F.wave); r < MV; r += (int)(gridDim.x * NWAVES)) {
        GAS f32x4* hp = (GAS f32x4*)(Hp + (size_t)r * DM) + F.lane; const GAS f32x4* yp = (const GAS f32x4*)(Yp + (size_t)r * DM) + F.lane;
        const GAS f32x4* tp = (const GAS f32x4*)(Y2p + (size_t)r * DM) + F.lane; GAS v2u* bo = (GAS v2u*)(HBp + (size_t)r * DM) + F.lane;
        GAS f32x4* op = (GAS f32x4*)(outp + (r < MP ? O_Y + (size_t)r * DM : O_YS + (size_t)(r - MP) * DM)) + F.lane;
#pragma unroll
        for (int j = 0; j < 8; ++j) { const f32x4 h = hp[64 * j], y = yp[64 * j], t = tp[64 * j]; f32x4 o;
            o.x = h.x + sigm(y.x) * t.x; o.y = h.y + sigm(y.y) * t.y; o.z = h.z + sigm(y.z) * t.z; o.w = h.w + sigm(y.w) * t.w;
            hp[64 * j] = o; v2u w; w.x = pk2(o.x, o.y); w.y = pk2(o.z, o.w); bo[64 * j] = w;
            if (l == NL - 1) op[64 * j] = o; }
    }
}

struct Args { const float* in[33]; float* out; unsigned char* ws; int ph_lo, ph_hi; };
constexpr int PH_PER_LAYER = 14, N_PHASES = 1 + NL * PH_PER_LAYER;
__global__ void __launch_bounds__(NWAVES * 64, 2) fwd(Args args) {
    extern __shared__ __attribute__((aligned(16))) unsigned char lds[];
    Frame F;
    F.lds = (LAS unsigned char*)lds;
    F.tid = threadIdx.x; F.lane = F.tid & 63; F.wave = __builtin_amdgcn_readfirstlane(F.tid >> 6);
    for (int u = F.tid; u < (LDS_BYTES - LDSCTL_OFF) / 4; u += NWAVES * 64) ((LAS unsigned*)(F.lds + LDSCTL_OFF))[u] = 0u;
    __syncthreads();
    if (MK_ONE_LAUNCH) (void)xcd_barrier_post((unsigned*)(ld_ws() + WS_CTL) + CW_BAR, (volatile LAS unsigned*)(F.lds + MISC_OFF) + 8);
#ifdef PH_LO
#define PLO PH_LO
#define PHI PH_HI
#else
#define PLO ld_argi(35 * 8)
#define PHI ld_argi(35 * 8 + 4)
#endif
#define IN(k) (PLO <= (k) && (k) < PHI)
#define SEAM(k) do { if (MK_ONE_LAUNCH && IN(k) && IN((k) + 1)) { XcdBarrier bar_; bar_.bar = (unsigned*)(ld_ws() + WS_CTL) + CW_BAR; bar_.x = xb_xcc_id(); bar_.st = (volatile LAS unsigned*)(F.lds + MISC_OFF) + 8; xcd_barrier(bar_); } } while (0)
    if (IN(0)) p0_prologue(F);
    SEAM(0);
    for (int l = 0; l < NL; ++l) {
        const int pb = 1 + l * PH_PER_LAYER;
        for (int half = 0; half < 2; ++half) {
            const int p0 = pb + half * 9;
            if (IN(p0)) {
                pg8::Gemm g{F.HB(), F.W() + (size_t)l * WLAYER + (half ? WGU2 : WGU1), MR, 2 * DFF, DM}; pg8::StaticOrder S; S.init(MR, 2 * DFF, (int)gridDim.x, (int)blockIdx.x);
                pg8::EpiSwiGLU E{F.ACT(), DFF};
                pg8::gemm_phase<pg8::EpiSwiGLU, pg8::StaticOrder, true, true>(F.lds + RING_OFF, g, S, E);
            }
            SEAM(p0);
            if (IN(p0 + 1)) {
                pg8::Gemm g{F.ACT(), F.W() + (size_t)l * WLAYER + (half ? WD2 : WD1), MR, DM, DFF}; pg8::StaticOrder S; S.init(MR, DM, (int)gridDim.x, (int)blockIdx.x);
                pg8::EpiF32 E{F.Y(), DM};
                pg8::gemm_phase<pg8::EpiF32, pg8::StaticOrder, true, true>(F.lds + RING_OFF, g, S, E);
            }
            SEAM(p0 + 1);
            if (IN(p0 + 2)) ln_pass(F, 0.5f, ld_arg(half ? I_ln3_g : I_ln1_g) + (size_t)l * DM, ld_arg(half ? I_ln3_b : I_ln1_b) + (size_t)l * DM);
            SEAM(p0 + 2);
            if (half == 0) {
                if (IN(pb + 3)) {
                    pg8::Gemm g{F.HB(), F.W() + (size_t)l * WLAYER + WIN, MR, DIN, DM}; pg8::StaticOrder S; S.init(MR, DIN, (int)gridDim.x, (int)blockIdx.x);
                    pg8::EpiBf16<0> E{F.Z(), DIN, nullptr, 0, 0, 1.f};
                    pg8::gemm_phase<pg8::EpiBf16<0>, pg8::StaticOrder, true, true>(F.lds + RING_OFF, g, S, E);
                }
                SEAM(pb + 3);
                if (IN(pb + 4)) mix0(F);
                SEAM(pb + 4);
                if (IN(pb + 5)) mix1(F, l);
                SEAM(pb + 5);
                if (IN(pb + 6)) mix2(F, l);
                SEAM(pb + 6);
                if (IN(pb + 7)) {
                    pg8::Gemm g{F.MIN(), F.W() + (size_t)l * WLAYER + WOUT, MR, DM, DM}; pg8::StaticOrder S; S.init(MR, DM, (int)gridDim.x, (int)blockIdx.x);
                    pg8::EpiF32 E{F.Y(), DM};
                    pg8::gemm_phase<pg8::EpiF32, pg8::StaticOrder, true, true>(F.lds + RING_OFF, g, S, E);
                }
                SEAM(pb + 7);
                if (IN(pb + 8)) ln_pass(F, 1.0f, ld_arg(I_ln2_g) + (size_t)l * DM, ld_arg(I_ln2_b) + (size_t)l * DM);
                SEAM(pb + 8);
            }
        }
        if (IN(pb + 12)) {
            { pg8::Gemm g{F.HB(), F.W() + (size_t)l * WLAYER + WPG, MR, DM, DM}; pg8::StaticOrder S; S.init(MR, DM, (int)gridDim.x, (int)blockIdx.x);
              pg8::EpiF32 E{F.Y(), DM};
              pg8::gemm_phase<pg8::EpiF32, pg8::StaticOrder, true, true>(F.lds + RING_OFF, g, S, E); }
            { pg8::Gemm g{F.PB() + (size_t)l * MR * DPLE, F.W() + (size_t)l * WLAYER + WPLE, MR, DM, DPLE}; pg8::StaticOrder S; S.init(MR, DM, (int)gridDim.x, (int)blockIdx.x);
              pg8::EpiF32 E{F.Y2(), DM};
              pg8::gemm_phase<pg8::EpiF32, pg8::StaticOrder, true, true>(F.lds + RING_OFF, g, S, E); }
        }
        SEAM(pb + 12);
        if (IN(pb + 13)) ple_pass(F, l);
        SEAM(pb + 13);
    }
#undef IN
#undef SEAM
}

extern "C" void kernel_launch(void* const* d_in, const int* in_sizes, int n_in, void* d_out, int out_size, void* d_ws, size_t ws_size, hipStream_t stream) {
    static int grid = 0;
    if (grid == 0) {
        if (n_in != 33 || in_sizes[0] != MP * DM || (size_t)out_size != O_END || ws_size < WS_END) { fprintf(stderr, "kernel_launch: unexpected shapes (n_in %d, in0 %d, out %d, ws %zu)\n", n_in, n_in > 0 ? in_sizes[0] : -1, out_size, ws_size); grid = -1; return; }
        int dev = 0, cus = 0, per_cu = 0;
        if (hipGetDevice(&dev) != hipSuccess || hipDeviceGetAttribute(&cus, hipDeviceAttributeMultiprocessorCount, dev) != hipSuccess) { grid = -1; return; }
        if (hipFuncSetAttribute((const void*)fwd, hipFuncAttributeMaxDynamicSharedMemorySize, LDS_BYTES) != hipSuccess) { fprintf(stderr, "kernel_launch: hipFuncSetAttribute failed\n"); grid = -1; return; }
        if (hipOccupancyMaxActiveBlocksPerMultiprocessor(&per_cu, (const void*)fwd, NWAVES * 64, LDS_BYTES) != hipSuccess || per_cu < 1) fprintf(stderr, "kernel_launch: occupancy query says %d\n", per_cu);
        (void)hipGetLastError();
        grid = cus;
    }
    if (grid < 0) return;
    if (hipMemsetAsync((char*)d_ws + WS_CTL, 0, CTL_ZERO_BYTES, stream) != hipSuccess) return;
    Args a{};
    for (int i = 0; i < 33; ++i) a.in[i] = (const float*)d_in[i];
    a.out = (float*)d_out; a.ws = (unsigned char*)d_ws;
#if MK_ONE_LAUNCH
    a.ph_lo = 0; a.ph_hi = N_PHASES;
    hipLaunchKernelGGL(fwd, dim3(grid), dim3(NWAVES * 64), LDS_BYTES, stream, a);
#else
    for (int p = 0; p < N_PHASES; ++p) { a.ph_lo = p; a.ph_hi = p + 1; hipLaunchKernelGGL(fwd, dim3(grid), dim3(NWAVES * 64), LDS_BYTES, stream, a); }
#endif
}
```

```cpp
#include <hip/hip_runtime.h>
#include <cstdio>
#include <cstdint>
#define MK_ONE_LAUNCH 1
namespace pg8 {
#define PG8_LAS __attribute__((address_space(3)))
typedef unsigned short bf16_t;
typedef short bf16x8 __attribute__((ext_vector_type(8)));
typedef float f32x4 __attribute__((ext_vector_type(4)));
typedef unsigned u32x4 __attribute__((ext_vector_type(4)));
constexpr int BM = 256, BK = 64, HALF = 128, HTB = HALF * BK * 2  , STAGE_BYTES = 8 * HTB, NXCD = 8, WGM = 8;

__host__ __device__ __forceinline__ int lds_byte(int r, int c) { const int st = (r >> 4) * 2 + (c >> 5), rr = r & 15, cc = c & 31, ob = rr * 64 + cc * 2; return st * 1024 + (ob ^ (((ob >> 9) & 1) << 5)); }
__host__ __device__ __forceinline__ void stage_rc(int b, int& R, int& C) { const int st = b / 1024, sb = b % 1024, swz = sb ^ (((sb >> 9) & 1) << 5); R = (st >> 1) * 16 + swz / 64; C = (st & 1) * 32 + (swz % 64) / 2; }
__host__ __device__ __forceinline__ int perm32(int rho) { const int n = rho >> 4, i = rho & 15; return 8 * (i >> 2) + 4 * n + (i & 3); }

struct Unit { int pm, pn; };
struct Gemm { const bf16_t* A; const bf16_t* Bt; int M, N, K; };

struct StaticOrder {
    int nM, nN, nwg, G, c;
    __host__ __device__ void init(int M, int N, int G_, int c_) { nM = M / BM; nN = N / BM; nwg = nM * nN; G = G_; c = c_; }
    __host__ __device__ bool next(int i, Unit& u) const {
        const long L = (long)i * G + c; if (L >= nwg) return false;
        int wgid = (int)L; { const int q = nwg / NXCD, r = nwg % NXCD, xcd = wgid % NXCD, off = wgid / NXCD; wgid = (xcd < r ? xcd * (q + 1) : r * (q + 1) + (xcd - r) * q) + off; }
        const int nig = WGM * nN, gid = wgid / nig, fm = gid * WGM, gsz = (nM - fm) < WGM ? (nM - fm) : WGM;
        u.pm = fm + ((wgid % nig) % gsz); u.pn = (wgid % nig) / gsz; return true;
    }
    __device__ __forceinline__ void a_ready(const Unit&) const {}
    __device__ __forceinline__ void done(const Unit&) const {}
};

__device__ __forceinline__ unsigned cvt_pk_bf16(float lo, float hi) { unsigned r; asm volatile("v_cvt_pk_bf16_f32 %0, %1, %2" : "=v"(r) : "v"(lo), "v"(hi)); return r; }
typedef float f32x2 __attribute__((ext_vector_type(2)));
__device__ __forceinline__ f32x2 gelu_pk(f32x2 v) {
    const f32x2 av = __builtin_elementwise_abs(v), d = av * 0.2316418882f + 1.0f;
    f32x2 t; t.x = __builtin_amdgcn_rcpf(d.x); t.y = __builtin_amdgcn_rcpf(d.y);
    f32x2 q = t * 0.5307027145f + (-0.7265760135f); q = q * t + 0.7107068705f; q = q * t + (-0.142248368f); q = q * t + 0.127414796f; q = q * t;
    const f32x2 s = (v * v) * (-0.72134752044f);
    f32x2 e; e.x = __builtin_amdgcn_exp2f(s.x); e.y = __builtin_amdgcn_exp2f(s.y);
    const f32x2 m = v * (q * e), r = v - m;
    f32x2 o; o.x = v.x < 0.f ? m.x : r.x; o.y = v.y < 0.f ? m.y : r.y; return o;
}

template <int ACT  > struct EpiBf16 {
    static constexpr bool PERM = true, AFTER_DRAIN = false; static_assert(ACT == 0 || ACT == 1, "EpiBf16: ACT is 0 (none) or 1 (gelu_pk)");
    bf16_t* O; int ldc; const float* bias; int split_cols; size_t split_stride; float scale0;
    __device__ __forceinline__ void operator()(const f32x4 (&acc)[2][2][4][2], const Unit& u, int wr, int wc, int fr, int fq) const {
        const int row0 = u.pm * BM + wr * 64 + fr; int colt = u.pn * BM; bf16_t* base = O;
        float sc = 1.f; if (split_cols) { const int t = colt / split_cols; base += (size_t)t * split_stride; colt -= t * split_cols; if (t == 0) sc = scale0; }
        const int col0 = colt + wc * 32 + 8 * fq, bcol0 = u.pn * BM + wc * 32 + 8 * fq;
        f32x4 bv[2][2];
#pragma unroll
        for (int bj = 0; bj < 2; ++bj)
#pragma unroll
            for (int n = 0; n < 2; ++n) bv[bj][n] = bias ? *(const f32x4*)(bias + bcol0 + bj * HALF + 4 * n) : (f32x4){0.f, 0.f, 0.f, 0.f};
#pragma unroll
        for (int ai = 0; ai < 2; ++ai)
#pragma unroll
            for (int m = 0; m < 4; ++m) { bf16_t* rowp = base + (size_t)(row0 + ai * HALF + m * 16) * ldc + col0;
#pragma unroll
                for (int bj = 0; bj < 2; ++bj) { f32x4 v0 = acc[ai][bj][m][0] + bv[bj][0], v1 = acc[ai][bj][m][1] + bv[bj][1];
                    if (ACT == 1) { f32x2 a = gelu_pk((f32x2){v0[0], v0[1]}), b = gelu_pk((f32x2){v0[2], v0[3]}), c = gelu_pk((f32x2){v1[0], v1[1]}), d = gelu_pk((f32x2){v1[2], v1[3]});
                        v0 = (f32x4){a.x, a.y, b.x, b.y}; v1 = (f32x4){c.x, c.y, d.x, d.y}; }
                    v0 = v0 * sc; v1 = v1 * sc; u32x4 w; w.x = cvt_pk_bf16(v0[0], v0[1]); w.y = cvt_pk_bf16(v0[2], v0[3]); w.z = cvt_pk_bf16(v1[0], v1[1]); w.w = cvt_pk_bf16(v1[2], v1[3]);
                    *(u32x4*)(rowp + bj * HALF) = w; } }
    }
};
__device__ __forceinline__ float silu_f(float x) { return x * __builtin_amdgcn_rcpf(1.0f + __builtin_amdgcn_exp2f(-1.4426950408889634f * x)); }
__device__ __forceinline__ float sigmoid_f(float x) { return __builtin_amdgcn_rcpf(1.0f + __builtin_amdgcn_exp2f(-1.4426950408889634f * x)); }
struct EpiF32 {
    static constexpr bool PERM = false, AFTER_DRAIN = false;
    float* C; int ldc;
    __device__ __forceinline__ void operator()(const f32x4 (&acc)[2][2][4][2], const Unit& u, int wr, int wc, int fr, int fq) const {
        const int row0 = u.pm * BM + wr * 64 + fr, col0 = u.pn * BM + wc * 32 + 4 * fq;
#pragma unroll
        for (int ai = 0; ai < 2; ++ai)
#pragma unroll
            for (int m = 0; m < 4; ++m) { float* rowp = C + (size_t)(row0 + ai * HALF + m * 16) * ldc + col0;
#pragma unroll
                for (int bj = 0; bj < 2; ++bj)
#pragma unroll
                    for (int n = 0; n < 2; ++n) *(f32x4*)(rowp + bj * HALF + n * 16) = acc[ai][bj][m][n]; }
    }
};
struct EpiSwiGLU {
    static constexpr bool PERM = true, AFTER_DRAIN = false;
    bf16_t* O; int ldc;
    __device__ __forceinline__ void operator()(const f32x4 (&acc)[2][2][4][2], const Unit& u, int wr, int wc, int fr, int fq) const {
        const int row0 = u.pm * BM + wr * 64 + fr, col0 = u.pn * HALF + wc * 32 + 8 * fq;
#pragma unroll
        for (int ai = 0; ai < 2; ++ai)
#pragma unroll
            for (int m = 0; m < 4; ++m) { bf16_t* rowp = O + (size_t)(row0 + ai * HALF + m * 16) * ldc + col0;
                const f32x4 g0 = acc[ai][0][m][0], g1 = acc[ai][0][m][1], u0 = acc[ai][1][m][0], u1 = acc[ai][1][m][1];
                u32x4 w;
                w.x = cvt_pk_bf16(silu_f(g0[0]) * u0[0], silu_f(g0[1]) * u0[1]); w.y = cvt_pk_bf16(silu_f(g0[2]) * u0[2], silu_f(g0[3]) * u0[3]);
                w.z = cvt_pk_bf16(silu_f(g1[0]) * u1[0], silu_f(g1[1]) * u1[1]); w.w = cvt_pk_bf16(silu_f(g1[2]) * u1[2], silu_f(g1[3]) * u1[3]);
                *(u32x4*)rowp = w; }
    }
};
template <class Epi, class Sched, bool ALIGN_EPI = false, bool SP2 = false>
__device__ __forceinline__ void gemm_phase(PG8_LAS unsigned char* lds, const Gemm g, const Sched& S, const Epi& E) {
    int tid_ = threadIdx.x; asm volatile("" : "+v"(tid_));
    const int tid = tid_, wid = __builtin_amdgcn_readfirstlane(tid >> 6), lane = tid & 63, wr = wid >> 2, wc = wid & 3, fr = lane & 15, fq = lane >> 4;
    const int K = g.K, nt = K / BK;
    unsigned voffA[2], voffB[2];
#pragma unroll
    for (int i = 0; i < 2; ++i) { int R, C; stage_rc(tid * 16 + i * 8192, R, C); const int Rb = Epi::PERM ? ((R & ~31) + perm32(R & 31)) : R;
        voffA[i] = (unsigned)(R * K + C) * 2u; voffB[i] = (unsigned)(Rb * K + C) * 2u; }
    const size_t kstep = (size_t)(BK * 2);
    const size_t hstep = (size_t)HALF * K * 2;
    const size_t tstep = 2 * hstep;
    const unsigned ldsw = (unsigned)wid * 1024u;
    const int aoff = lds_byte(wr * 64 + fr, fq * 8), boff = lds_byte(wc * 32 + fr, fq * 8);
#define PG8_SA(b, h) (((b) * 2 + (h)) * HTB)
#define PG8_SB(b, h) ((4 + (b) * 2 + (h)) * HTB)
#define PG8_STAGE(bufoff, gbase, voff) do { _Pragma("unroll") for (int _i = 0; _i < 2; ++_i) \
        __builtin_amdgcn_global_load_lds((const unsigned*)((const char*)(gbase) + (voff)[_i]), (PG8_LAS unsigned*)(lds + (bufoff) + ldsw + _i * 8192), 16, 0, 0); } while (0)
#define PG8_LDA(dst, b, h) do { _Pragma("unroll") for (int m = 0; m < 4; ++m) _Pragma("unroll") for (int k = 0; k < 2; ++k) dst[m][k] = *(const PG8_LAS bf16x8*)(lds + PG8_SA(b, h) + aoff + m * 2048 + k * 1024); } while (0)
#define PG8_LDB(dst, b, h) do { _Pragma("unroll") for (int n = 0; n < 2; ++n) _Pragma("unroll") for (int k = 0; k < 2; ++k) dst[n][k] = *(const PG8_LAS bf16x8*)(lds + PG8_SB(b, h) + boff + n * 2048 + k * 1024); } while (0)
#define PG8_MMA(ai, bj, At, Bt) do { __builtin_amdgcn_s_setprio(1); _Pragma("unroll") for (int m = 0; m < 4; ++m) _Pragma("unroll") for (int n = 0; n < 2; ++n) _Pragma("unroll") for (int k = 0; k < 2; ++k) \
        acc[ai][bj][m][n] = __builtin_amdgcn_mfma_f32_16x16x32_bf16(Bt[n][k], At[m][k], acc[ai][bj][m][n], 0, 0, 0); __builtin_amdgcn_s_setprio(0); } while (0)
#define PG8_WAIT_V(n) asm volatile("s_waitcnt vmcnt(" #n ")" ::: "memory")
#define PG8_WAIT_L(n) asm volatile("s_waitcnt lgkmcnt(" #n ")" ::: "memory")
#define PG8_BAR __builtin_amdgcn_s_barrier()
#define PG8_SCHED __builtin_amdgcn_sched_barrier(0)
    Unit cur, nxt; int ui = 0;
    if (!S.next(0, cur)) return;
    f32x4 acc[2][2][4][2];
#pragma unroll
    for (int a = 0; a < 2; ++a)
#pragma unroll
        for (int b = 0; b < 2; ++b)
#pragma unroll
            for (int m = 0; m < 4; ++m)
#pragma unroll
                for (int n = 0; n < 2; ++n) acc[a][b][m][n] = (f32x4){0.f, 0.f, 0.f, 0.f};
    bf16x8 At[4][2], B0[2][2], B1[2][2];
    const char* cA = (const char*)g.A + (size_t)cur.pm * tstep; const char* cB = (const char*)g.Bt + (size_t)cur.pn * tstep;
    S.a_ready(cur);
    if constexpr (SP2) {
        PG8_STAGE(PG8_SB(0, 0), cB, voffB); PG8_STAGE(PG8_SB(0, 1), cB + hstep, voffB); PG8_STAGE(PG8_SA(0, 0), cA, voffA); PG8_STAGE(PG8_SA(0, 1), cA + hstep, voffA);
        if (wr == 1) PG8_BAR;
        PG8_WAIT_V(2); PG8_BAR;
        PG8_STAGE(PG8_SB(1, 0), cB + kstep, voffB); PG8_STAGE(PG8_SA(1, 0), cA + kstep, voffA); PG8_STAGE(PG8_SB(1, 1), cB + hstep + kstep, voffB);
        PG8_WAIT_V(6); PG8_BAR;
    } else {
        PG8_STAGE(PG8_SB(0, 0), cB, voffB); PG8_STAGE(PG8_SA(0, 0), cA, voffA); PG8_STAGE(PG8_SB(0, 1), cB + hstep, voffB); PG8_STAGE(PG8_SA(0, 1), cA + hstep, voffA);
        if (wr == 1) PG8_BAR;
        PG8_WAIT_V(4); PG8_BAR;
        PG8_STAGE(PG8_SB(1, 0), cB + kstep, voffB); PG8_STAGE(PG8_SA(1, 0), cA + kstep, voffA); PG8_STAGE(PG8_SB(1, 1), cB + hstep + kstep, voffB);
        PG8_WAIT_V(6); PG8_BAR;
    }
    for (;;) {
        const bool has_next = S.next(ui + 1, nxt);
        const char* nA = has_next ? (const char*)g.A + (size_t)nxt.pm * tstep : cA; const char* nB = has_next ? (const char*)g.Bt + (size_t)nxt.pn * tstep : cB;
        for (int t = 0; t < nt; t += 2) {
            const bool last = (t == nt - 2);
            const char* a1 = cA + (size_t)(t + 1) * kstep;
            const char* a2 = last ? nA : cA + (size_t)(t + 2) * kstep; const char* b2 = last ? nB : cB + (size_t)(t + 2) * kstep;
            const char* a3 = a2 + kstep; const char* b3 = b2 + kstep;
            if (last && has_next) S.a_ready(nxt);
            if constexpr (SP2) {
            PG8_LDB(B0, 0, 0); PG8_LDB(B1, 0, 1); PG8_SCHED; PG8_LDA(At, 0, 0); PG8_STAGE(PG8_SA(1, 1), a1 + hstep, voffA);
            PG8_WAIT_V(8); PG8_WAIT_L(0); PG8_BAR; PG8_MMA(0, 0, At, B0); PG8_MMA(0, 1, At, B1); PG8_BAR; PG8_SCHED;
            PG8_LDA(At, 0, 1); PG8_STAGE(PG8_SB(0, 0), b2, voffB); PG8_STAGE(PG8_SB(0, 1), b2 + hstep, voffB); PG8_STAGE(PG8_SA(0, 0), a2, voffA);
            PG8_WAIT_V(8); PG8_WAIT_L(0); PG8_BAR; PG8_MMA(1, 0, At, B0); PG8_MMA(1, 1, At, B1); PG8_BAR; PG8_SCHED;
            PG8_LDB(B0, 1, 0); PG8_LDB(B1, 1, 1); PG8_SCHED; PG8_LDA(At, 1, 0); PG8_STAGE(PG8_SA(0, 1), a2 + hstep, voffA);
            PG8_WAIT_V(8); PG8_WAIT_L(0); PG8_BAR; PG8_MMA(0, 0, At, B0); PG8_MMA(0, 1, At, B1); PG8_BAR; PG8_SCHED;
            PG8_LDA(At, 1, 1); PG8_STAGE(PG8_SB(1, 0), b3, voffB); PG8_STAGE(PG8_SB(1, 1), b3 + hstep, voffB); PG8_STAGE(PG8_SA(1, 0), a3, voffA);
            PG8_WAIT_V(8); PG8_WAIT_L(0); PG8_BAR; PG8_MMA(1, 0, At, B0); PG8_MMA(1, 1, At, B1); PG8_BAR; PG8_SCHED;
            } else {
            PG8_LDB(B0, 0, 0); PG8_SCHED; PG8_LDA(At, 0, 0); PG8_STAGE(PG8_SA(1, 1), a1 + hstep, voffA);
            PG8_WAIT_L(8); PG8_BAR; PG8_WAIT_L(0); PG8_MMA(0, 0, At, B0); PG8_BAR; PG8_SCHED;
            PG8_LDB(B1, 0, 1); PG8_STAGE(PG8_SB(0, 0), b2, voffB);
            PG8_BAR; PG8_WAIT_L(0); PG8_MMA(0, 1, At, B1); PG8_BAR;
            PG8_LDA(At, 0, 1); PG8_STAGE(PG8_SA(0, 0), a2, voffA);
            PG8_BAR; PG8_WAIT_L(0); PG8_MMA(1, 0, At, B0); PG8_BAR; PG8_SCHED;
            PG8_STAGE(PG8_SB(0, 1), b2 + hstep, voffB);
            PG8_WAIT_V(6); PG8_BAR; PG8_MMA(1, 1, At, B1); PG8_BAR;
            PG8_LDB(B0, 1, 0); PG8_SCHED; PG8_LDA(At, 1, 0); PG8_STAGE(PG8_SA(0, 1), a2 + hstep, voffA);
            PG8_WAIT_L(8); PG8_BAR; PG8_WAIT_L(0); PG8_MMA(0, 0, At, B0); PG8_BAR; PG8_SCHED;
            PG8_LDB(B1, 1, 1); PG8_STAGE(PG8_SB(1, 0), b3, voffB);
            PG8_BAR; PG8_WAIT_L(0); PG8_MMA(0, 1, At, B1); PG8_BAR;
            PG8_LDA(At, 1, 1); PG8_STAGE(PG8_SA(1, 0), a3, voffA);
            PG8_BAR; PG8_WAIT_L(0); PG8_MMA(1, 0, At, B0); PG8_BAR; PG8_SCHED;
            PG8_STAGE(PG8_SB(1, 1), b3 + hstep, voffB);
            PG8_WAIT_V(6); PG8_BAR; PG8_MMA(1, 1, At, B1); PG8_BAR;
            }
        }
        if constexpr (ALIGN_EPI) { if (wr == 0) PG8_BAR; }
        if constexpr (!Epi::AFTER_DRAIN) { E(acc, cur, wr, wc, fr, fq); S.done(cur); }
        if (!has_next) break;
#pragma unroll
        for (int a = 0; a < 2; ++a)
#pragma unroll
            for (int b = 0; b < 2; ++b)
#pragma unroll
                for (int m = 0; m < 4; ++m)
#pragma unroll
                    for (int n = 0; n < 2; ++n) acc[a][b][m][n] = (f32x4){0.f, 0.f, 0.f, 0.f};
        cur = nxt; cA = nA; cB = nB; ++ui;
        if constexpr (ALIGN_EPI) { if (wr == 1) PG8_BAR; }
    }
    PG8_WAIT_V(0);
    if constexpr (!ALIGN_EPI) { if (wr == 0) PG8_BAR; }
    PG8_BAR;
    if constexpr (Epi::AFTER_DRAIN) { E.fused(acc, cur, wr, wc, fr, fq, lds, wid, lane); S.done(cur); }
#undef PG8_SA
#undef PG8_SB
#undef PG8_STAGE
#undef PG8_LDA
#undef PG8_LDB
#undef PG8_MMA
#undef PG8_WAIT_V
#undef PG8_WAIT_L
#undef PG8_BAR
#undef PG8_SCHED
}
}
constexpr int NWAVES = 8;
#ifndef MK_ONE_LAUNCH
#define MK_ONE_LAUNCH 1
#endif
constexpr int DM = 2048, DFF = 5632, DIN = 3072, NL = 4, DPLE = 256;
constexpr int MP = 8192, MS = 32, MV = MP + MS, MR = 8448;
constexpr int SEQ = 2048, NBATCH = 4;
constexpr float LN_EPS = 1e-5f, ALPHA = 1.6817928305074290f;
constexpr int ZU = 0, ZA = 512, ZG = 1024, ZQ = 1536, ZK = 2560, ZV = 2816;
constexpr size_t WGU1 = 0, WD1 = WGU1 + (size_t)2 * DFF * DM, WIN = WD1 + (size_t)DM * DFF, WOUT = WIN + (size_t)DIN * DM, WGU2 = WOUT + (size_t)DM * DM,
                 WD2 = WGU2 + (size_t)2 * DFF * DM, WPG = WD2 + (size_t)DM * DFF, WPLE = WPG + (size_t)DM * DM, WPOOL = WPLE + (size_t)DM * DPLE, WPW = WPOOL + 4 * 128 * 128,
                 WLAYER = WPW + 512 * 512;
constexpr size_t MiB = 1u << 20;
constexpr size_t WS_CTL = 0, CTL_ZERO_BYTES = 1 * MiB;
constexpr size_t WS_BIAS = 1 * MiB;
constexpr size_t WS_W = 2 * MiB;
constexpr size_t WS_H = 650 * MiB;
constexpr size_t WS_HB = 716 * MiB;
constexpr size_t WS_Y = 749 * MiB;
constexpr size_t WS_ACT = 815 * MiB;
constexpr size_t WS_Z = 906 * MiB;
constexpr size_t WS_MIN = 956 * MiB;
constexpr size_t WS_X = 989 * MiB;
constexpr size_t WS_C = 1006 * MiB;
constexpr size_t WS_VT = 1023 * MiB;
constexpr size_t WS_PB = 1027 * MiB;
constexpr size_t WS_END = 1044 * MiB;
static_assert(WS_W + 4 * WLAYER * 2 <= WS_H, "weights fit");
static_assert((size_t)MR * DM * 4 == 66 * MiB, "row buffers");
constexpr int CW_BAR = 4096;
constexpr size_t O_Y = 0, O_YS = O_Y + (size_t)MP * DM, O_KP = O_YS + (size_t)MS * DM, O_VP = O_KP + (size_t)NL * 4 * 128 * 256, O_PP = O_VP + (size_t)NL * 4 * 128 * 256,
                 O_CP = O_PP + (size_t)NL * 4 * 15 * 512, O_KS = O_CP + (size_t)NL * 4 * 30 * 512, O_VS = O_KS + (size_t)NL * 32 * 128 * 256, O_PS = O_VS + (size_t)NL * 32 * 128 * 256,
                 O_CS = O_PS + (size_t)NL * 32 * 15 * 512, O_END = O_CS + (size_t)NL * 32 * 30 * 512;
constexpr int RING_OFF = 0, RING_BYTES = 131072, LDSCTL_OFF = RING_BYTES, MISC_OFF = LDSCTL_OFF + 320, LDS_BYTES = 147456;

#define GAS __attribute__((address_space(1)))
#define LAS __attribute__((address_space(3)))
typedef unsigned short bf16;
typedef unsigned v4u __attribute__((ext_vector_type(4)));
typedef unsigned v2u __attribute__((ext_vector_type(2)));
typedef float f32x4 __attribute__((ext_vector_type(4)));
typedef short bf16x8 __attribute__((ext_vector_type(8)));
typedef GAS unsigned gu32;
#define RLX_AGENT __ATOMIC_RELAXED, __HIP_MEMORY_SCOPE_AGENT
#define LDS_WAIT() asm volatile("s_waitcnt lgkmcnt(0)" ::: "memory")
#define VM_WAIT() asm volatile("s_waitcnt vmcnt(0)" ::: "memory")
__device__ __forceinline__ unsigned f2bf(float f) { unsigned u = __builtin_bit_cast(unsigned, f); return (u + 0x7fffu + ((u >> 16) & 1u)) >> 16; }
__device__ __forceinline__ unsigned pk2(float lo, float hi) { return f2bf(lo) | (f2bf(hi) << 16); }
__device__ __forceinline__ float bf2f(unsigned short b) { return __uint_as_float((unsigned)b << 16); }
__device__ __forceinline__ float bflo(unsigned w) { return __uint_as_float(w << 16); }
__device__ __forceinline__ float bfhi(unsigned w) { return __uint_as_float(w & 0xffff0000u); }
__device__ __forceinline__ void unpack8(v4u v, float (&f)[8]) { f[0] = bflo(v.x); f[1] = bfhi(v.x); f[2] = bflo(v.y); f[3] = bfhi(v.y); f[4] = bflo(v.z); f[5] = bfhi(v.z); f[6] = bflo(v.w); f[7] = bfhi(v.w); }
__device__ __forceinline__ float sigm(float x) { return __builtin_amdgcn_rcpf(1.0f + __builtin_amdgcn_exp2f(-1.4426950408889634f * x)); }
__device__ __forceinline__ float wave_sum(float v) {
#pragma unroll
    for (int o = 1; o < 64; o <<= 1) v += __shfl_xor(v, o);
    return v;
}
__device__ __forceinline__ float wave_max(float v) {
#pragma unroll
    for (int o = 1; o < 64; o <<= 1) v = fmaxf(v, __shfl_xor(v, o));
    return v;
}
#define XB_TMO      128
#define XB_XCNT(j)  (256  + 64 * (j))
#define XB_XSUB(j)  (1280 + 64 * (j))
#define XB_XGEN(j)  (2304 + 64 * (j))
#define XB_TOP      3328
#define XB_TOPGEN   3392
#define XCD_BAR_WORDS 3456
#define XB_SPIN_CAP (1u << 18)

__device__ __forceinline__ unsigned xb_ld(unsigned* p)              { return __hip_atomic_load(p, __ATOMIC_RELAXED, __HIP_MEMORY_SCOPE_AGENT); }
__device__ __forceinline__ unsigned xb_add(unsigned* p, unsigned v) { return __hip_atomic_fetch_add(p, v, __ATOMIC_RELAXED, __HIP_MEMORY_SCOPE_AGENT); }
__device__ __forceinline__ unsigned xb_xcc_id() { return (unsigned)__builtin_amdgcn_s_getreg((3 << 11) | 20) & 0xFu; }
#define XB_SPIN(cond, bar) do { unsigned _sp = 0; while (cond) { __builtin_amdgcn_s_sleep(1); \
    if ((++_sp & 255u) == 0u) { if (xb_ld(&(bar)[XB_TMO])) break; if (_sp > XB_SPIN_CAP) { atomicAdd(&(bar)[XB_TMO], 1u); break; } } } } while (0)

struct XcdBarrier {
    unsigned* bar; unsigned x;
    volatile LAS unsigned* st;
};

__device__ __forceinline__ XcdBarrier xcd_barrier_post(unsigned* bar, volatile LAS unsigned* st) {
    XcdBarrier b; b.bar = bar; b.x = xb_xcc_id(); b.st = st;
    if (threadIdx.x == 0) (void)xb_add(&bar[XB_XCNT(b.x)], 1u);
    return b;
}
__device__ __forceinline__ void xcd_barrier_complete(unsigned* bar, unsigned x, unsigned& nloc, unsigned& nx) {
    const unsigned G = gridDim.x * gridDim.y * gridDim.z;
    unsigned sum, cnt, mine, sp = 0u;
    for (;;) {
        sum = 0u; cnt = 0u; mine = 0u;
#pragma unroll
        for (unsigned j = 0; j < 16; ++j) { const unsigned c = xb_ld(&bar[XB_XCNT(j)]); sum += c; cnt += (c > 0u) ? 1u : 0u; mine = (j == x) ? c : mine; }
        if (sum == G) break;
        __builtin_amdgcn_s_sleep(1);
        if ((++sp & 255u) == 0u) { if (xb_ld(&bar[XB_TMO])) break; if (sp > XB_SPIN_CAP) { atomicAdd(&bar[XB_TMO], 1u); break; } }
    }
    nloc = mine > 0u ? mine : 1u; nx = cnt > 0u ? cnt : 1u;
}

__device__ __forceinline__ void xcd_barrier(const XcdBarrier& b) {
    asm volatile("s_waitcnt vmcnt(0)" ::: "memory");
    __syncthreads();
    if (threadIdx.x == 0) {
        unsigned* bar = b.bar;
        __builtin_amdgcn_s_waitcnt(0);
        unsigned nloc = b.st[0], nx = b.st[1];
        if (nloc == 0u) { xcd_barrier_complete(bar, b.x, nloc, nx); b.st[0] = nloc; b.st[1] = nx; }
        const unsigned old = xb_add(&bar[XB_XSUB(b.x)], 1u);
        const unsigned gen = old / nloc;
        if (old + 1u == (gen + 1u) * nloc) {
            __builtin_amdgcn_fence(__ATOMIC_RELEASE, "agent");
            asm volatile("s_waitcnt vmcnt(0)" ::: "memory");
            const unsigned og = xb_add(&bar[XB_TOP], 1u);
            const unsigned tg = og / nx;
            if (og + 1u == (tg + 1u) * nx) xb_add(&bar[XB_TOPGEN], 1u);
            else XB_SPIN(xb_ld(&bar[XB_TOPGEN]) == tg, bar);
            __builtin_amdgcn_fence(__ATOMIC_ACQUIRE, "agent");
            xb_add(&bar[XB_XGEN(b.x)], 1u);
            asm volatile("s_waitcnt vmcnt(0)" ::: "memory");
        } else {
            XB_SPIN(xb_ld(&bar[XB_XGEN(b.x)]) == gen, bar);
            __builtin_amdgcn_fence(__ATOMIC_ACQUIRE, "agent");
            asm volatile("s_waitcnt vmcnt(0)" ::: "memory");
        }
    }
    __syncthreads();
}
enum InIdx { I_x_prompt = 0, I_x_sample, I_p_prompt, I_p_sample, I_cache_k, I_cache_v, I_state_pool, I_state_conv, I_rel_bias, I_ln1_g, I_ln1_b, I_w_gate1, I_w_up1, I_w_down1, I_w_in, I_w_pool, I_pool_scale,
    I_w_dw, I_b_dw, I_conv_ln_g, I_conv_ln_b, I_w_pw, I_sinks, I_w_out, I_ln2_g, I_ln2_b, I_w_gate2, I_w_up2, I_w_down2, I_ln3_g, I_ln3_b, I_w_pg, I_w_ple };
__device__ __forceinline__ const float* ld_arg(int i) {
    const __attribute__((address_space(4))) char* ka = (const __attribute__((address_space(4))) char*)__builtin_amdgcn_kernarg_segment_ptr();
    asm volatile("" : "+s"(ka));
    return *(const float* const __attribute__((address_space(4)))*)(ka + 8 * i);
}
__device__ __forceinline__ unsigned char* ld_ws() { return (unsigned char*)ld_arg(34); }
__device__ __forceinline__ float* ld_out() { return (float*)ld_arg(33); }
__device__ __forceinline__ int ld_argi(int byte_off) {
    const __attribute__((address_space(4))) char* ka = (const __attribute__((address_space(4))) char*)__builtin_amdgcn_kernarg_segment_ptr();
    asm volatile("" : "+s"(ka));
    return *(const int __attribute__((address_space(4)))*)(ka + byte_off);
}
struct Frame {
    LAS unsigned char* lds;
    int tid, lane, wave;
    __device__ __forceinline__ float* biasT() const { return (float*)(ld_ws() + WS_BIAS); }
    __device__ __forceinline__ bf16* W() const { return (bf16*)(ld_ws() + WS_W); }
    __device__ __forceinline__ float* H() const { return (float*)(ld_ws() + WS_H); }
    __device__ __forceinline__ bf16* HB() const { return (bf16*)(ld_ws() + WS_HB); }
    __device__ __forceinline__ float* Y() const { return (float*)(ld_ws() + WS_Y); }
    __device__ __forceinline__ bf16* ACT() const { return (bf16*)(ld_ws() + WS_ACT); }
    __device__ __forceinline__ float* Y2() const { return (float*)(ld_ws() + WS_ACT); }
    __device__ __forceinline__ bf16* Z() const { return (bf16*)(ld_ws() + WS_Z); }
    __device__ __forceinline__ bf16* MIN() const { return (bf16*)(ld_ws() + WS_MIN); }
    __device__ __forceinline__ bf16* X() const { return (bf16*)(ld_ws() + WS_X); }
    __device__ __forceinline__ float* C() const { return (float*)(ld_ws() + WS_C); }
    __device__ __forceinline__ bf16* VT() const { return (bf16*)(ld_ws() + WS_VT); }
    __device__ __forceinline__ bf16* PB() const { return (bf16*)(ld_ws() + WS_PB); }
};

#define FRAME_LOCAL(F, F0) Frame F = F0; asm volatile("" : "+v"(F.lane), "+v"(F.tid), "+s"(F.wave))
__device__ __forceinline__ void transpose_item(const float* W, int K, int N, bf16* WT, int mode, LAS float* scr, int item, int lane) {
    const int nblk = N / 32, kb = item / nblk, nb = item % nblk, k0 = 64 * kb, n0 = 32 * nb;
    const int drow0 = mode == 0 ? n0 : (256 * (n0 >> 7) + (n0 & 127) + (mode == 2 ? 128 : 0));
#pragma unroll 8
    for (int i = 0; i < 32; ++i) { const int kk = 2 * i + (lane >> 5); scr[kk * 33 + (lane & 31)] = W[(size_t)(k0 + kk) * N + n0 + (lane & 31)]; }
    LDS_WAIT(); asm volatile("" ::: "memory");
    const int c = lane & 7;
#pragma unroll
    for (int j = 0; j < 4; ++j) { const int n = (lane >> 3) + 8 * j; const LAS float* s = scr + (8 * c) * 33 + n;
        v4u o; o.x = pk2(s[0 * 33], s[1 * 33]); o.y = pk2(s[2 * 33], s[3 * 33]); o.z = pk2(s[4 * 33], s[5 * 33]); o.w = pk2(s[6 * 33], s[7 * 33]);
        *(GAS v4u*)(WT + (size_t)(drow0 + n) * K + k0 + 8 * c) = o; }
    LDS_WAIT(); asm volatile("" ::: "memory");
}
__device__ __forceinline__ int t5_bucket(int n) {
    if (n < 16) return n;
    const int lb = 16 + (int)(__logf((float)n * (1.0f / 16.0f)) * (16.0f / 2.0794415416798357f));
    return lb < 31 ? lb : 31;
}
__device__ __forceinline__ void p0_prologue(Frame& F0) {
    FRAME_LOCAL(F, F0);
    LAS float* scr = (LAS float*)(F.lds + RING_OFF + F.wave * 16384);
    constexpr int I_GU = (DM / 64) * (DFF / 32), I_D = (DFF / 64) * (DM / 32), I_IN = (DM / 64) * (DIN / 32), I_SQ = (DM / 64) * (DM / 32), I_PLE = (DPLE / 64) * (DM / 32), I_POOL = 4 * 2 * 4, I_PW = 8 * 16;
    constexpr int I_LAYER = 4 * I_GU + 2 * I_D + I_IN + 2 * I_SQ + I_PLE + I_POOL + I_PW;
    bf16* Wp = F.W();
    for (int it = (int)(blockIdx.x * NWAVES + F.wave); it < NL * I_LAYER; it += (int)(gridDim.x * NWAVES)) {
        const int l = it / I_LAYER; int r = it % I_LAYER;
        bf16* Wl = Wp + (size_t)l * WLAYER;
        if (r < I_GU) { transpose_item(ld_arg(I_w_gate1) + (size_t)l * DM * DFF, DM, DFF, Wl + WGU1, 1, scr, r, F.lane); continue; } r -= I_GU;
        if (r < I_GU) { transpose_item(ld_arg(I_w_up1) + (size_t)l * DM * DFF, DM, DFF, Wl + WGU1, 2, scr, r, F.lane); continue; } r -= I_GU;
        if (r < I_D) { transpose_item(ld_arg(I_w_down1) + (size_t)l * DM * DFF, DFF, DM, Wl + WD1, 0, scr, r, F.lane); continue; } r -= I_D;
        if (r < I_IN) { transpose_item(ld_arg(I_w_in) + (size_t)l * DM * DIN, DM, DIN, Wl + WIN, 0, scr, r, F.lane); continue; } r -= I_IN;
        if (r < I_SQ) { transpose_item(ld_arg(I_w_out) + (size_t)l * DM * DM, DM, DM, Wl + WOUT, 0, scr, r, F.lane); continue; } r -= I_SQ;
        if (r < I_GU) { transpose_item(ld_arg(I_w_gate2) + (size_t)l * DM * DFF, DM, DFF, Wl + WGU2, 1, scr, r, F.lane); continue; } r -= I_GU;
        if (r < I_GU) { transpose_item(ld_arg(I_w_up2) + (size_t)l * DM * DFF, DM, DFF, Wl + WGU2, 2, scr, r, F.lane); continue; } r -= I_GU;
        if (r < I_D) { transpose_item(ld_arg(I_w_down2) + (size_t)l * DM * DFF, DFF, DM, Wl + WD2, 0, scr, r, F.lane); continue; } r -= I_D;
        if (r < I_SQ) { transpose_item(ld_arg(I_w_pg) + (size_t)l * DM * DM, DM, DM, Wl + WPG, 0, scr, r, F.lane); continue; } r -= I_SQ;
        if (r < I_PLE) { transpose_item(ld_arg(I_w_ple) + (size_t)l * DPLE * DM, DPLE, DM, Wl + WPLE, 0, scr, r, F.lane); continue; } r -= I_PLE;
        if (r < I_POOL) { const int g = r >> 3; transpose_item(ld_arg(I_w_pool) + (size_t)(l * 4 + g) * 128 * 128, 128, 128, Wl + WPOOL + (size_t)g * 128 * 128, 0, scr, r & 7, F.lane); continue; } r -= I_POOL;
        transpose_item(ld_arg(I_w_pw) + (size_t)l * 512 * 512, 512, 512, Wl + WPW, 0, scr, r, F.lane);
    }
    float* Hp = F.H(); bf16* HBp = F.HB(); bf16* PBp = F.PB(); float* biasTp = F.biasT();
    const float* x_prompt = ld_arg(I_x_prompt); const float* x_sample = ld_arg(I_x_sample); const float* p_prompt = ld_arg(I_p_prompt); const float* p_sample = ld_arg(I_p_sample); const float* rel_bias = ld_arg(I_rel_bias);
    for (int r = (int)(blockIdx.x * NWAVES + F.wave); r < MR; r += (int)(gridDim.x * NWAVES)) {
        const float* src = r < MP ? x_prompt + (size_t)r * DM : (r < MV ? x_sample + (size_t)(r - MP) * DM : nullptr);
        GAS f32x4* ho = (GAS f32x4*)(Hp + (size_t)r * DM) + F.lane; GAS v2u* bo = (GAS v2u*)(HBp + (size_t)r * DM) + F.lane;
#pragma unroll
        for (int j = 0; j < 8; ++j) { f32x4 v = src ? ((const GAS f32x4*)src)[F.lane + 64 * j] : (f32x4){0.f, 0.f, 0.f, 0.f};
            ho[64 * j] = v; v2u o; o.x = pk2(v.x, v.y); o.y = pk2(v.z, v.w); bo[64 * j] = o; }
    }
    for (int i = (int)(blockIdx.x * NWAVES + F.wave); i < NL * MR; i += (int)(gridDim.x * NWAVES)) {
        const int l = i / MR, r = i % MR;
        const float* src = r < MP ? p_prompt + ((size_t)l * MP + r) * DPLE : (r < MV ? p_sample + ((size_t)l * MS + (r - MP)) * DPLE : nullptr);
        f32x4 v = src ? ((const GAS f32x4*)src)[F.lane] : (f32x4){0.f, 0.f, 0.f, 0.f};
        v2u o; o.x = pk2(v.x, v.y); o.y = pk2(v.z, v.w); ((GAS v2u*)(PBp + (size_t)i * DPLE))[F.lane] = o;
    }
    { const int gt = blockIdx.x * (NWAVES * 64) + F.tid;
      if (gt < 16 * 128) { const int h = gt >> 7, dist = gt & 127; biasTp[gt] = rel_bias[t5_bucket(dist) * 16 + h]; } }
}

__device__ __forceinline__ void ln_pass(Frame& F0, float coef, const float* g, const float* b) {
    FRAME_LOCAL(F, F0);
    float* Hp = F.H(); const float* Yp = F.Y(); bf16* HBp = F.HB();
    for (int r = (int)(blockIdx.x * NWAVES + F.wave); r < MV; r += (int)(gridDim.x * NWAVES)) {
        GAS f32x4* hp = (GAS f32x4*)(Hp + (size_t)r * DM) + F.lane; const GAS f32x4* yp = (const GAS f32x4*)(Yp + (size_t)r * DM) + F.lane;
        f32x4 v[8]; float s = 0.f;
#pragma unroll
        for (int j = 0; j < 8; ++j) { const f32x4 h = hp[64 * j], y = yp[64 * j]; v[j] = h * ALPHA + y * coef; s += (v[j].x + v[j].y) + (v[j].z + v[j].w); }
        const float mean = wave_sum(s) * (1.f / DM); float s2 = 0.f;
#pragma unroll
        for (int j = 0; j < 8; ++j) { v[j] = v[j] - mean; s2 += (v[j].x * v[j].x + v[j].y * v[j].y) + (v[j].z * v[j].z + v[j].w * v[j].w); }
        const float rstd = 1.f / sqrtf(wave_sum(s2) * (1.f / DM) + LN_EPS);
        GAS v2u* bo = (GAS v2u*)(HBp + (size_t)r * DM) + F.lane;
#pragma unroll
        for (int j = 0; j < 8; ++j) { const f32x4 gg = ((const GAS f32x4*)g)[F.lane + 64 * j], bb = ((const GAS f32x4*)b)[F.lane + 64 * j];
            const f32x4 o = v[j] * rstd * gg + bb; hp[64 * j] = o; v2u w; w.x = pk2(o.x, o.y); w.y = pk2(o.z, o.w); bo[64 * j] = w; }
    }
}

__device__ __forceinline__ void mix0(Frame& F0) {
    FRAME_LOCAL(F, F0);
    const bf16* Zp = F.Z(); float* Cp = F.C(); bf16* VTp = F.VT();
    for (int r = (int)(blockIdx.x * NWAVES + F.wave); r < MV; r += (int)(gridDim.x * NWAVES)) {
        const bf16* zr = Zp + (size_t)r * DIN; float a[8], g[8];
        unpack8(*(const GAS v4u*)(zr + ZA + F.lane * 8), a); unpack8(*(const GAS v4u*)(zr + ZG + F.lane * 8), g);
        f32x4 c0, c1; c0.x = a[0] * sigm(g[0]); c0.y = a[1] * sigm(g[1]); c0.z = a[2] * sigm(g[2]); c0.w = a[3] * sigm(g[3]);
        c1.x = a[4] * sigm(g[4]); c1.y = a[5] * sigm(g[5]); c1.z = a[6] * sigm(g[6]); c1.w = a[7] * sigm(g[7]);
        GAS f32x4* cp = (GAS f32x4*)(Cp + (size_t)r * 512 + F.lane * 8); cp[0] = c0; cp[1] = c1;
    }
    for (int t = (int)(blockIdx.x * NWAVES + F.wave); t < 4 * 4 * 32; t += (int)(gridDim.x * NWAVES)) {
        const int ch = t & 31, kvh = (t >> 5) & 3, b = t >> 7, tok = ch * 64 + F.lane;
        const bf16* zr = Zp + (size_t)(b * SEQ + tok) * DIN + ZV + kvh * 64; bf16* vt = VTp + (size_t)((b * 4 + kvh) * 64) * SEQ + tok;
#pragma unroll
        for (int dc = 0; dc < 8; ++dc) { const v4u v = *(const GAS v4u*)(zr + dc * 8);
            vt[(size_t)(dc * 8 + 0) * SEQ] = (bf16)(v.x & 0xffffu); vt[(size_t)(dc * 8 + 1) * SEQ] = (bf16)(v.x >> 16);
            vt[(size_t)(dc * 8 + 2) * SEQ] = (bf16)(v.y & 0xffffu); vt[(size_t)(dc * 8 + 3) * SEQ] = (bf16)(v.y >> 16);
            vt[(size_t)(dc * 8 + 4) * SEQ] = (bf16)(v.z & 0xffffu); vt[(size_t)(dc * 8 + 5) * SEQ] = (bf16)(v.z >> 16);
            vt[(size_t)(dc * 8 + 6) * SEQ] = (bf16)(v.w & 0xffffu); vt[(size_t)(dc * 8 + 7) * SEQ] = (bf16)(v.w >> 16); }
    }
}

__device__ __forceinline__ void mix1(Frame& F0, int l) {
    FRAME_LOCAL(F, F0);
    const int ch = F.lane * 8, grp = F.lane >> 4, w = 2 << grp;
    const float* state_pool = ld_arg(I_state_pool); const float* state_conv = ld_arg(I_state_conv); const float* b_dw = ld_arg(I_b_dw); const float* w_dw = ld_arg(I_w_dw); const float* conv_ln_g = ld_arg(I_conv_ln_g); const float* conv_ln_b = ld_arg(I_conv_ln_b);
    const bf16* Zp = F.Z(); bf16* Xp = F.X(); const float* Cp = F.C();
    for (int r = (int)(blockIdx.x * NWAVES + F.wave); r < MV; r += (int)(gridDim.x * NWAVES)) {
        const bool smp = r >= MP; const int b = smp ? r - MP : r / SEQ, t = smp ? 0 : r % SEQ;
        float cur[8], sum[8];
        unpack8(*(const GAS v4u*)(Zp + (size_t)r * DIN + ZU + ch), cur);
#pragma unroll
        for (int j = 0; j < 8; ++j) sum[j] = cur[j];
        for (int i = 1; i < 16; ++i) {
            if (i < w) {
                if (!smp) { if (t - i >= 0) { float u[8]; unpack8(*(const GAS v4u*)(Zp + (size_t)(r - i) * DIN + ZU + ch), u);
#pragma unroll
                        for (int j = 0; j < 8; ++j) sum[j] += u[j]; } }
                else { const GAS f32x4* sp = (const GAS f32x4*)(state_pool + ((size_t)(l * MS + b) * 15 + (15 - i)) * 512 + ch); const f32x4 u0 = sp[0], u1 = sp[1];
                    sum[0] += u0.x; sum[1] += u0.y; sum[2] += u0.z; sum[3] += u0.w; sum[4] += u1.x; sum[5] += u1.y; sum[6] += u1.z; sum[7] += u1.w; }
            }
        }
        { const int cnt = smp ? w : ((t + 1) < w ? (t + 1) : w); const float inv = 1.0f / (float)cnt;
          v4u o; o.x = pk2(sum[0] * inv - cur[0], sum[1] * inv - cur[1]); o.y = pk2(sum[2] * inv - cur[2], sum[3] * inv - cur[3]);
          o.z = pk2(sum[4] * inv - cur[4], sum[5] * inv - cur[5]); o.w = pk2(sum[6] * inv - cur[6], sum[7] * inv - cur[7]);
          *(GAS v4u*)(Xp + (size_t)r * 1024 + ch) = o; }
        float acc[8];
        { const GAS f32x4* bp = (const GAS f32x4*)(b_dw + (size_t)l * 512 + ch); const f32x4 b0 = bp[0], b1 = bp[1];
          acc[0] = b0.x; acc[1] = b0.y; acc[2] = b0.z; acc[3] = b0.w; acc[4] = b1.x; acc[5] = b1.y; acc[6] = b1.z; acc[7] = b1.w; }
        for (int j = 0; j < 31; ++j) {
            const float* src;
            if (!smp) { const int tt = t - 30 + j; if (tt < 0) continue; src = Cp + (size_t)(r - 30 + j) * 512 + ch; }
            else src = (j == 30) ? Cp + (size_t)r * 512 + ch : state_conv + ((size_t)(l * MS + b) * 30 + j) * 512 + ch;
            const f32x4 c0 = ((const GAS f32x4*)src)[0], c1 = ((const GAS f32x4*)src)[1];
            const GAS f32x4* wp = (const GAS f32x4*)(w_dw + ((size_t)l * 31 + j) * 512 + ch); const f32x4 w0 = wp[0], w1 = wp[1];
            acc[0] += c0.x * w0.x; acc[1] += c0.y * w0.y; acc[2] += c0.z * w0.z; acc[3] += c0.w * w0.w;
            acc[4] += c1.x * w1.x; acc[5] += c1.y * w1.y; acc[6] += c1.z * w1.z; acc[7] += c1.w * w1.w;
        }
        float s = 0.f;
#pragma unroll
        for (int j = 0; j < 8; ++j) s += acc[j];
        const float mean = wave_sum(s) * (1.f / 512.f); float s2 = 0.f;
#pragma unroll
        for (int j = 0; j < 8; ++j) { acc[j] -= mean; s2 += acc[j] * acc[j]; }
        const float rstd = 1.f / sqrtf(wave_sum(s2) * (1.f / 512.f) + LN_EPS);
        { const GAS f32x4* gp = (const GAS f32x4*)(conv_ln_g + (size_t)l * 512 + ch); const GAS f32x4* bp = (const GAS f32x4*)(conv_ln_b + (size_t)l * 512 + ch);
          const f32x4 g0 = gp[0], g1 = gp[1], b0 = bp[0], b1 = bp[1]; float y[8];
          y[0] = acc[0] * rstd * g0.x + b0.x; y[1] = acc[1] * rstd * g0.y + b0.y; y[2] = acc[2] * rstd * g0.z + b0.z; y[3] = acc[3] * rstd * g0.w + b0.w;
          y[4] = acc[4] * rstd * g1.x + b1.x; y[5] = acc[5] * rstd * g1.y + b1.y; y[6] = acc[6] * rstd * g1.z + b1.z; y[7] = acc[7] * rstd * g1.w + b1.w;
#pragma unroll
          for (int j = 0; j < 8; ++j) y[j] = y[j] * sigm(y[j]);
          v4u o; o.x = pk2(y[0], y[1]); o.y = pk2(y[2], y[3]); o.z = pk2(y[4], y[5]); o.w = pk2(y[6], y[7]);
          *(GAS v4u*)(Xp + (size_t)r * 1024 + 512 + ch) = o; }
    }
}

#define MFMA16(a, b, c) __builtin_amdgcn_mfma_f32_16x16x32_bf16((a), (b), (c), 0, 0, 0)
__device__ __forceinline__ void wave_gemm_32x64(const bf16* A, int lda, const bf16* Bt, int ldb, int K, int lane, f32x4 (&acc)[2][4]) {
    const int fr = lane & 15, fq = lane >> 4;
#pragma unroll
    for (int mi = 0; mi < 2; ++mi)
#pragma unroll
        for (int ni = 0; ni < 4; ++ni) acc[mi][ni] = (f32x4){0.f, 0.f, 0.f, 0.f};
    const bf16* ap = A + (size_t)fr * lda + fq * 8; const bf16* bp = Bt + (size_t)fr * ldb + fq * 8;
    for (int k0 = 0; k0 < K; k0 += 32) {
        bf16x8 a[2], b[4];
#pragma unroll
        for (int mi = 0; mi < 2; ++mi) a[mi] = *(const GAS bf16x8*)(ap + (size_t)mi * 16 * lda + k0);
#pragma unroll
        for (int ni = 0; ni < 4; ++ni) b[ni] = *(const GAS bf16x8*)(bp + (size_t)ni * 16 * ldb + k0);
#pragma unroll
        for (int mi = 0; mi < 2; ++mi)
#pragma unroll
            for (int ni = 0; ni < 4; ++ni) acc[mi][ni] = MFMA16(b[ni], a[mi], acc[mi][ni]);
    }
}
__device__ __forceinline__ void attn_prompt_task(Frame& F, int l, int task, const float* sinks) {
    const int qt = task & 127, h = (task >> 7) & 15, b = task >> 11, kvh = h >> 2;
    const int fr = F.lane & 15, fq = F.lane >> 4, t0 = qt * 16;
    const bf16* zb = F.Z() + (size_t)(b * SEQ) * DIN;
    bf16x8 qf[2];
#pragma unroll
    for (int ks = 0; ks < 2; ++ks) qf[ks] = *(const GAS bf16x8*)(zb + (size_t)(t0 + fr) * DIN + ZQ + h * 64 + ks * 32 + fq * 8);
    f32x4 s[10];
#pragma unroll
    for (int kt = 0; kt < 10; ++kt) {
        int key = t0 - 128 + kt * 16 + fr; key = key < 0 ? 0 : (key > SEQ - 1 ? SEQ - 1 : key);
        const bf16* kp = zb + (size_t)key * DIN + ZK + kvh * 64 + fq * 8;
        const bf16x8 k0 = *(const GAS bf16x8*)kp, k1 = *(const GAS bf16x8*)(kp + 32);
        f32x4 a = (f32x4){0.f, 0.f, 0.f, 0.f};
        a = MFMA16(k0, qf[0], a); a = MFMA16(k1, qf[1], a); s[kt] = a;
    }
    const float sink = sinks[l * 16 + h]; const float* bt = F.biasT() + h * 128;
    float m = sink;
#pragma unroll
    for (int kt = 0; kt < 10; ++kt)
#pragma unroll
        for (int r = 0; r < 4; ++r) { const int key = t0 - 128 + kt * 16 + fq * 4 + r, dist = t0 + fr - key; const bool valid = (dist >= 0) && (dist < 128) && (key >= 0);
            const float v = valid ? s[kt][r] * 0.125f + bt[dist & 127] : -1e30f; s[kt][r] = v; m = fmaxf(m, v); }
    m = fmaxf(m, __shfl_xor(m, 16)); m = fmaxf(m, __shfl_xor(m, 32));
    float sum = 0.f;
#pragma unroll
    for (int kt = 0; kt < 10; ++kt)
#pragma unroll
        for (int r = 0; r < 4; ++r) { const float e = __expf(s[kt][r] - m); s[kt][r] = e; sum += e; }
    sum += __shfl_xor(sum, 16); sum += __shfl_xor(sum, 32);
    sum += __expf(sink - m);
    const float inv = 1.0f / sum;
    f32x4 o[4];
#pragma unroll
    for (int dt = 0; dt < 4; ++dt) o[dt] = (f32x4){0.f, 0.f, 0.f, 0.f};
    const bf16* vt = F.VT() + (size_t)((b * 4 + kvh) * 64) * SEQ;
#pragma unroll
    for (int i = 0; i < 5; ++i) {
        v4u pw; pw.x = pk2(s[2 * i][0] * inv, s[2 * i][1] * inv); pw.y = pk2(s[2 * i][2] * inv, s[2 * i][3] * inv);
        pw.z = pk2(s[2 * i + 1][0] * inv, s[2 * i + 1][1] * inv); pw.w = pk2(s[2 * i + 1][2] * inv, s[2 * i + 1][3] * inv);
        const bf16x8 pb = __builtin_bit_cast(bf16x8, pw);
        int ka = t0 - 128 + 32 * i + 4 * fq, kb = ka + 16;
        ka = ka < 0 ? 0 : (ka > SEQ - 4 ? SEQ - 4 : ka); kb = kb < 0 ? 0 : (kb > SEQ - 4 ? SEQ - 4 : kb);
#pragma unroll
        for (int dt = 0; dt < 4; ++dt) { const bf16* vp = vt + (size_t)(dt * 16 + fr) * SEQ;
            const v2u va = *(const GAS v2u*)(vp + ka), vb = *(const GAS v2u*)(vp + kb);
            v4u vw; vw.x = va.x; vw.y = va.y; vw.z = vb.x; vw.w = vb.y;
            o[dt] = MFMA16(__builtin_bit_cast(bf16x8, vw), pb, o[dt]); }
    }
    bf16* op = F.MIN() + (size_t)(b * SEQ + t0 + fr) * DM + 1024 + h * 64 + 4 * fq;
#pragma unroll
    for (int dt = 0; dt < 4; ++dt) { v2u w; w.x = pk2(o[dt][0], o[dt][1]); w.y = pk2(o[dt][2], o[dt][3]); *(GAS v2u*)(op + dt * 16) = w; }
}
__device__ __forceinline__ void attn_sample_task(Frame& F, int l, int task, LAS float* scr, const float* sinks, const float* cache_k, const float* cache_v) {
    const int b = task >> 4, h = task & 15, kvh = h >> 2, row = MP + b, lane = F.lane;
    const bf16* zr = F.Z() + (size_t)row * DIN;
    const float qd = bf2f(zr[ZQ + h * 64 + lane]);
    scr[lane] = qd; LDS_WAIT();
    const float* ck = cache_k + ((size_t)(l * MS + b) * 128 * 4 + kvh) * 64; const float* cv = cache_v + ((size_t)(l * MS + b) * 128 * 4 + kvh) * 64;
    float s0 = 0.f, s1 = 0.f;
#pragma unroll 4
    for (int d4 = 0; d4 < 16; ++d4) { const f32x4 q4 = *(const LAS f32x4*)(scr + 4 * d4);
        const f32x4 a = *(const GAS f32x4*)(ck + (size_t)lane * 256 + 4 * d4), c = *(const GAS f32x4*)(ck + (size_t)(lane + 64) * 256 + 4 * d4);
        s0 += q4.x * a.x + q4.y * a.y + q4.z * a.z + q4.w * a.w; s1 += q4.x * c.x + q4.y * c.y + q4.z * c.z + q4.w * c.w; }
    const float sn = wave_sum(qd * bf2f(zr[ZK + kvh * 64 + lane]));
    const float sink = sinks[l * 16 + h]; const float* bt = F.biasT() + h * 128;
    const float v0 = lane >= 1 ? s0 * 0.125f + bt[(128 - lane) & 127] : -1e30f, v1 = s1 * 0.125f + bt[64 - lane], vn = sn * 0.125f + bt[0];
    const float m = fmaxf(fmaxf(wave_max(fmaxf(v0, v1)), vn), sink);
    const float e0 = __expf(v0 - m), e1 = __expf(v1 - m), en = __expf(vn - m);
    const float inv = 1.0f / (wave_sum(e0 + e1) + en + __expf(sink - m));
    LDS_WAIT();
    scr[64 + lane] = e0 * inv; scr[128 + lane] = e1 * inv; LDS_WAIT();
    float o = en * inv * bf2f(zr[ZV + kvh * 64 + lane]);
#pragma unroll 8
    for (int j = 0; j < 128; ++j) o += scr[64 + j] * cv[(size_t)j * 256 + lane];
    F.MIN()[(size_t)row * DM + 1024 + h * 64 + lane] = (bf16)f2bf(o);
    LDS_WAIT();
}
__device__ __forceinline__ void mix2(Frame& F0, int l) {
    FRAME_LOCAL(F, F0);
    const bf16* Wl = F.W() + (size_t)l * WLAYER; const int lane = F.lane, fr = lane & 15, fq = lane >> 4;
    const bf16* Zp = F.Z(); const bf16* Xp = F.X(); bf16* MINp = F.MIN(); const float* Cp = F.C();
    float* outp = ld_out();
    const float* pool_scale = ld_arg(I_pool_scale); const float* sinks = ld_arg(I_sinks); const float* cache_k = ld_arg(I_cache_k); const float* cache_v = ld_arg(I_cache_v); const float* state_pool = ld_arg(I_state_pool); const float* state_conv = ld_arg(I_state_conv);
    for (int t = (int)(blockIdx.x * NWAVES + F.wave); t < 257 * 8; t += (int)(gridDim.x * NWAVES)) { const int rt = t >> 3, ct = t & 7; f32x4 acc[2][4];
        wave_gemm_32x64(Xp + (size_t)rt * 32 * 1024 + 512, 1024, Wl + WPW + (size_t)ct * 64 * 512, 512, 512, lane, acc);
#pragma unroll
        for (int mi = 0; mi < 2; ++mi)
#pragma unroll
            for (int ni = 0; ni < 4; ++ni) { v2u w; w.x = pk2(acc[mi][ni][0], acc[mi][ni][1]); w.y = pk2(acc[mi][ni][2], acc[mi][ni][3]);
                *(GAS v2u*)(MINp + (size_t)(rt * 32 + mi * 16 + fr) * DM + 512 + ct * 64 + ni * 16 + 4 * fq) = w; } }
    for (int t = (int)(blockIdx.x * NWAVES + F.wave); t < 257 * 8; t += (int)(gridDim.x * NWAVES)) { const int rt = t >> 3, g = (t >> 1) & 3, ct = t & 1; f32x4 acc[2][4];
        wave_gemm_32x64(Xp + (size_t)rt * 32 * 1024 + g * 128, 1024, Wl + WPOOL + (size_t)(g * 128 + ct * 64) * 128, 128, 128, lane, acc);
#pragma unroll
        for (int ni = 0; ni < 4; ++ni) { const int col = g * 128 + ct * 64 + ni * 16 + 4 * fq; const f32x4 sc = *(const GAS f32x4*)(pool_scale + (size_t)l * 512 + col);
#pragma unroll
            for (int mi = 0; mi < 2; ++mi) { const f32x4 v = acc[mi][ni] * sc; v2u w; w.x = pk2(v[0], v[1]); w.y = pk2(v[2], v[3]);
                *(GAS v2u*)(MINp + (size_t)(rt * 32 + mi * 16 + fr) * DM + col) = w; } } }
    for (int t = (int)(blockIdx.x * NWAVES + F.wave); t < NBATCH * 16 * 128; t += (int)(gridDim.x * NWAVES)) attn_prompt_task(F, l, t, sinks);
    { LAS float* scr = (LAS float*)(F.lds + RING_OFF + F.wave * 1024);
      for (int t = (int)(blockIdx.x * NWAVES + F.wave); t < MS * 16; t += (int)(gridDim.x * NWAVES)) attn_sample_task(F, l, t, scr, sinks, cache_k, cache_v); }
    for (int t = (int)(blockIdx.x * NWAVES + F.wave); t < NBATCH * 128; t += (int)(gridDim.x * NWAVES)) { const int b = t >> 7, j = t & 127; float v[8];
        unpack8(*(const GAS v4u*)(Zp + (size_t)(b * SEQ + SEQ - 128 + j) * DIN + ZK + lane * 8), v);
        float* dst = outp + (lane < 32 ? O_KP : O_VP) + ((size_t)(l * NBATCH + b) * 128 + j) * 256 + (lane & 31) * 8;
        ((GAS f32x4*)dst)[0] = (f32x4){v[0], v[1], v[2], v[3]}; ((GAS f32x4*)dst)[1] = (f32x4){v[4], v[5], v[6], v[7]}; }
    for (int t = (int)(blockIdx.x * NWAVES + F.wave); t < NBATCH * 15; t += (int)(gridDim.x * NWAVES)) { const int b = t / 15, i = t % 15; float v[8];
        unpack8(*(const GAS v4u*)(Zp + (size_t)(b * SEQ + SEQ - 15 + i) * DIN + ZU + lane * 8), v);
        float* dst = outp + O_PP + ((size_t)(l * NBATCH + b) * 15 + i) * 512 + lane * 8;
        ((GAS f32x4*)dst)[0] = (f32x4){v[0], v[1], v[2], v[3]}; ((GAS f32x4*)dst)[1] = (f32x4){v[4], v[5], v[6], v[7]}; }
    for (int t = (int)(blockIdx.x * NWAVES + F.wave); t < NBATCH * 30; t += (int)(gridDim.x * NWAVES)) { const int b = t / 30, i = t % 30;
        const GAS f32x4* src = (const GAS f32x4*)(Cp + (size_t)(b * SEQ + SEQ - 30 + i) * 512 + lane * 8);
        float* dst = outp + O_CP + ((size_t)(l * NBATCH + b) * 30 + i) * 512 + lane * 8;
        ((GAS f32x4*)dst)[0] = src[0]; ((GAS f32x4*)dst)[1] = src[1]; }
    for (int t = (int)(blockIdx.x * NWAVES + F.wave); t < MS * 128; t += (int)(gridDim.x * NWAVES)) { const int b = t >> 7, j = t & 127;
        float* dk = outp + O_KS + ((size_t)(l * MS + b) * 128 + j) * 256 + lane * 4; float* dv = outp + O_VS + ((size_t)(l * MS + b) * 128 + j) * 256 + lane * 4;
        if (j < 127) { *(GAS f32x4*)dk = *(const GAS f32x4*)(cache_k + ((size_t)(l * MS + b) * 128 + j + 1) * 256 + lane * 4);
                       *(GAS f32x4*)dv = *(const GAS f32x4*)(cache_v + ((size_t)(l * MS + b) * 128 + j + 1) * 256 + lane * 4); }
        else { const bf16* zr = Zp + (size_t)(MP + b) * DIN; const v2u kk = *(const GAS v2u*)(zr + ZK + lane * 4), vv = *(const GAS v2u*)(zr + ZV + lane * 4);
               *(GAS f32x4*)dk = (f32x4){bflo(kk.x), bfhi(kk.x), bflo(kk.y), bfhi(kk.y)}; *(GAS f32x4*)dv = (f32x4){bflo(vv.x), bfhi(vv.x), bflo(vv.y), bfhi(vv.y)}; } }
    for (int t = (int)(blockIdx.x * NWAVES + F.wave); t < MS * 15; t += (int)(gridDim.x * NWAVES)) { const int b = t / 15, i = t % 15; float* dst = outp + O_PS + ((size_t)(l * MS + b) * 15 + i) * 512 + lane * 8;
        if (i < 14) { const GAS f32x4* src = (const GAS f32x4*)(state_pool + ((size_t)(l * MS + b) * 15 + i + 1) * 512 + lane * 8); ((GAS f32x4*)dst)[0] = src[0]; ((GAS f32x4*)dst)[1] = src[1]; }
        else { float v[8]; unpack8(*(const GAS v4u*)(Zp + (size_t)(MP + b) * DIN + ZU + lane * 8), v);
               ((GAS f32x4*)dst)[0] = (f32x4){v[0], v[1], v[2], v[3]}; ((GAS f32x4*)dst)[1] = (f32x4){v[4], v[5], v[6], v[7]}; } }
    for (int t = (int)(blockIdx.x * NWAVES + F.wave); t < MS * 30; t += (int)(gridDim.x * NWAVES)) { const int b = t / 30, i = t % 30; float* dst = outp + O_CS + ((size_t)(l * MS + b) * 30 + i) * 512 + lane * 8;
        const GAS f32x4* src = (const GAS f32x4*)((i < 29 ? state_conv + ((size_t)(l * MS + b) * 30 + i + 1) * 512 : Cp + (size_t)(MP + b) * 512) + lane * 8);
        ((GAS f32x4*)dst)[0] = src[0]; ((GAS f32x4*)dst)[1] = src[1]; }
}

__device__ __forceinline__ void ple_pass(Frame& F0, int l) {
    FRAME_LOCAL(F, F0);
    float* outp = ld_out(); float* Hp = F.H(); const float* Yp = F.Y(); const float* Y2p = F.Y2(); bf16* HBp = F.HB();
    for (int r = (int)(blockIdx.x * NWAVES + F.wave); r < MV; r += (int)(gridDim.x * NWAVES)) {
        GAS f32x4* hp = (GAS f32x4*)(Hp + (size_t)r * DM) + F.lane; const GAS f32x4* yp = (const GAS f32x4*)(Yp + (size_t)r * DM) + F.lane;
        const GAS f32x4* tp = (const GAS f32x4*)(Y2p + (size_t)r * DM) + F.lane; GAS v2u* bo = (GAS v2u*)(HBp + (size_t)r * DM) + F.lane;
        GAS f32x4* op = (GAS f32x4*)(outp + (r < MP ? O_Y + (size_t)r * DM : O_YS + (size_t)(r - MP) * DM)) + F.lane;
#pragma unroll
        for (int j = 0; j < 8; ++j) { const f32x4 h = hp[64 * j], y = yp[64 * j], t = tp[64 * j]; f32x4 o;
            o.x = h.x + sigm(y.x) * t.x; o.y = h.y + sigm(y.y) * t.y; o.z = h.z + sigm(y.z) * t.z; o.w = h.w + sigm(y.w) * t.w;
            hp[64 * j] = o; v2u w; w.x = pk2(o.x, o.y); w.y = pk2(o.z, o.w); bo[64 * j] = w;
            if (l == NL - 1) op[64 * j] = o; }
    }
}

struct Args { const float* in[33]; float* out; unsigned char* ws; int ph_lo, ph_hi; };
constexpr int PH_PER_LAYER = 14, N_PHASES = 1 + NL * PH_PER_LAYER;
__global__ void __launch_bounds__(NWAVES * 64, 2) fwd(Args args) {
    extern __shared__ __attribute__((aligned(16))) unsigned char lds[];
    Frame F;
    F.lds = (LAS unsigned char*)lds;
    F.tid = threadIdx.x; F.lane = F.tid & 63; F.wave = __builtin_amdgcn_readfirstlane(F.tid >> 6);
    for (int u = F.tid; u < (LDS_BYTES - LDSCTL_OFF) / 4; u += NWAVES * 64) ((LAS unsigned*)(F.lds + LDSCTL_OFF))[u] = 0u;
    __syncthreads();
    if (MK_ONE_LAUNCH) (void)xcd_barrier_post((unsigned*)(ld_ws() + WS_CTL) + CW_BAR, (volatile LAS unsigned*)(F.lds + MISC_OFF) + 8);
#ifdef PH_LO
#define PLO PH_LO
#define PHI PH_HI
#else
#define PLO ld_argi(35 * 8)
#define PHI ld_argi(35 * 8 + 4)
#endif
#define IN(k) (PLO <= (k) && (k) < PHI)
#define SEAM(k) do { if (MK_ONE_LAUNCH && IN(k) && IN((k) + 1)) { XcdBarrier bar_; bar_.bar = (unsigned*)(ld_ws() + WS_CTL) + CW_BAR; bar_.x = xb_xcc_id(); bar_.st = (volatile LAS unsigned*)(F.lds + MISC_OFF) + 8; xcd_barrier(bar_); } } while (0)
    if (IN(0)) p0_prologue(F);
    SEAM(0);
    for (int l = 0; l < NL; ++l) {
        const int pb = 1 + l * PH_PER_LAYER;
        for (int half = 0; half < 2; ++half) {
            const int p0 = pb + half * 9;
            if (IN(p0)) {
                pg8::Gemm g{F.HB(), F.W() + (size_t)l * WLAYER + (half ? WGU2 : WGU1), MR, 2 * DFF, DM}; pg8::StaticOrder S; S.init(MR, 2 * DFF, (int)gridDim.x, (int)blockIdx.x);
                pg8::EpiSwiGLU E{F.ACT(), DFF};
                pg8::gemm_phase<pg8::EpiSwiGLU, pg8::StaticOrder, true, true>(F.lds + RING_OFF, g, S, E);
            }
            SEAM(p0);
            if (IN(p0 + 1)) {
                pg8::Gemm g{F.ACT(), F.W() + (size_t)l * WLAYER + (half ? WD2 : WD1), MR, DM, DFF}; pg8::StaticOrder S; S.init(MR, DM, (int)gridDim.x, (int)blockIdx.x);
                pg8::EpiF32 E{F.Y(), DM};
                pg8::gemm_phase<pg8::EpiF32, pg8::StaticOrder, true, true>(F.lds + RING_OFF, g, S, E);
            }
            SEAM(p0 + 1);
            if (IN(p0 + 2)) ln_pass(F, 0.5f, ld_arg(half ? I_ln3_g : I_ln1_g) + (size_t)l * DM, ld_arg(half ? I_ln3_b : I_ln1_b) + (size_t)l * DM);
            SEAM(p0 + 2);
            if (half == 0) {
                if (IN(pb + 3)) {
                    pg8::Gemm g{F.HB(), F.W() + (size_t)l * WLAYER + WIN, MR, DIN, DM}; pg8::StaticOrder S; S.init(MR, DIN, (int)gridDim.x, (int)blockIdx.x);
                    pg8::EpiBf16<0> E{F.Z(), DIN, nullptr, 0, 0, 1.f};
                    pg8::gemm_phase<pg8::EpiBf16<0>, pg8::StaticOrder, true, true>(F.lds + RING_OFF, g, S, E);
                }
                SEAM(pb + 3);
                if (IN(pb + 4)) mix0(F);
                SEAM(pb + 4);
                if (IN(pb + 5)) mix1(F, l);
                SEAM(pb + 5);
                if (IN(pb + 6)) mix2(F, l);
                SEAM(pb + 6);
                if (IN(pb + 7)) {
                    pg8::Gemm g{F.MIN(), F.W() + (size_t)l * WLAYER + WOUT, MR, DM, DM}; pg8::StaticOrder S; S.init(MR, DM, (int)gridDim.x, (int)blockIdx.x);
                    pg8::EpiF32 E{F.Y(), DM};
                    pg8::gemm_phase<pg8::EpiF32, pg8::StaticOrder, true, true>(F.lds + RING_OFF, g, S, E);
                }
                SEAM(pb + 7);
                if (IN(pb + 8)) ln_pass(F, 1.0f, ld_arg(I_ln2_g) + (size_t)l * DM, ld_arg(I_ln2_b) + (size_t)l * DM);
                SEAM(pb + 8);
            }
        }
        if (IN(pb + 12)) {
            { pg8::Gemm g{F.HB(), F.W() + (size_t)l * WLAYER + WPG, MR, DM, DM}; pg8::StaticOrder S; S.init(MR, DM, (int)gridDim.x, (int)blockIdx.x);
              pg8::EpiF32 E{F.Y(), DM};
              pg8::gemm_phase<pg8::EpiF32, pg8::StaticOrder, true, true>(F.lds + RING_OFF, g, S, E); }
            { pg8::Gemm g{F.PB() + (size_t)l * MR * DPLE, F.W() + (size_t)l * WLAYER + WPLE, MR, DM, DPLE}; pg8::StaticOrder S; S.init(MR, DM, (int)gridDim.x, (int)blockIdx.x);
              pg8::EpiF32 E{F.Y2(), DM};
              pg8::gemm_phase<pg8::EpiF32, pg8::StaticOrder, true, true>(F.lds + RING_OFF, g, S, E); }
        }
        SEAM(pb + 12);
        if (IN(pb + 13)) ple_pass(F, l);
        SEAM(pb + 13);
    }
#undef IN
#undef SEAM
}

extern "C" void kernel_launch(void* const* d_in, const int* in_sizes, int n_in, void* d_out, int out_size, void* d_ws, size_t ws_size, hipStream_t stream) {
    static int grid = 0;
    if (grid == 0) {
        if (n_in != 33 || in_sizes[0] != MP * DM || (size_t)out_size != O_END || ws_size < WS_END) { fprintf(stderr, "kernel_launch: unexpected shapes (n_in %d, in0 %d, out %d, ws %zu)\n", n_in, n_in > 0 ? in_sizes[0] : -1, out_size, ws_size); grid = -1; return; }
        int dev = 0, cus = 0, per_cu = 0;
        if (hipGetDevice(&dev) != hipSuccess || hipDeviceGetAttribute(&cus, hipDeviceAttributeMultiprocessorCount, dev) != hipSuccess) { grid = -1; return; }
        if (hipFuncSetAttribute((const void*)fwd, hipFuncAttributeMaxDynamicSharedMemorySize, LDS_BYTES) != hipSuccess) { fprintf(stderr, "kernel_launch: hipFuncSetAttribute failed\n"); grid = -1; return; }
        if (hipOccupancyMaxActiveBlocksPerMultiprocessor(&per_cu, (const void*)fwd, NWAVES * 64, LDS_BYTES) != hipSuccess || per_cu < 1) fprintf(stderr, "kernel_launch: occupancy query says %d\n", per_cu);
        (void)hipGetLastError();
        grid = cus;
    }
    if (grid < 0) return;
    if (hipMemsetAsync((char*)d_ws + WS_CTL, 0, CTL_ZERO_BYTES, stream) != hipSuccess) return;
    Args a{};
    for (int i = 0; i < 33; ++i) a.in[i] = (const float*)d_in[i];
    a.out = (float*)d_out; a.ws = (unsigned char*)d_ws;
#if MK_ONE_LAUNCH
    a.ph_lo = 0; a.ph_hi = N_PHASES;
    hipLaunchKernelGGL(fwd, dim3(grid), dim3(NWAVES * 64), LDS_BYTES, stream, a);
#else
    for (int p = 0; p < N_PHASES; ++p) { a.ph_lo = p; a.ph_hi = p + 1; hipLaunchKernelGGL(fwd, dim3(grid), dim3(NWAVES * 64), LDS_BYTES, stream, a); }
#endif
}
```
